# Optimizing an MI355X kernel written in HIP

```python
import math
import jax, jax.numpy as jnp
from jax import lax
import numpy as np

D_MODEL = 1024
BATCH = 8
SEQ = 4096
DEPTH = 1

GRID_W = 64
CTX_LEN = 256
D_HYENA = 512
HYENA_ORDER = 2
FILTER_EMB = 33
FILTER_WIDTH = 64
FILTER_TARGET = 1e-2
FAST_DECAY_PCT = 0.3
SLOW_DECAY_PCT = 1.5
N_HEADS = 4
HEAD_DIM = 64
D_ATTN = N_HEADS * 2 * HEAD_DIM
ROPE_BASE = 10000.0
Q_BLOCK = 128
D_FF = ((8 * D_MODEL + 3 * 256 - 1) // (3 * 256)) * 256
EPS = 1e-6
OFF_Q = (HYENA_ORDER + 1) * D_HYENA
OFF_K = OFF_Q + D_ATTN
OFF_V = OFF_K + D_ATTN
OFF_G = OFF_V + D_ATTN
N_COLS = OFF_G + 2 * D_MODEL

kernel_name = 'hybrid_hyena_diffattn_dit_block'


def rmsnorm(x, g):
    xf = x.astype(jnp.float32)
    y = xf * lax.rsqrt(jnp.mean(xf * xf, axis=-1, keepdims=True) + EPS)
    return (y * g.astype(jnp.float32)).astype(x.dtype)


def modulate(h, shift, scale):
    return h * (1.0 + scale) + shift


def short_conv(u, w, b):
    L = u.shape[1]
    up = jnp.pad(u, ((0, 0), (1, 1), (0, 0)))
    return up[:, :L] * w[0] + up[:, 1:L + 1] * w[1] + up[:, 2:] * w[2] + b


def hyena_filters(L, fw1, fb1, fw2, fb2, fw3, fb3, ffreq):
    f32 = jnp.float32
    bands = (FILTER_EMB - 1) // 2
    t = jnp.linspace(0.0, 1.0, L, dtype=f32)[:, None]
    w = (2.0 * math.pi / L) * jnp.arange(L, dtype=f32)[:, None]
    fr = jnp.linspace(1e-4, bands - 1, bands, dtype=f32)[None, :]
    z = jnp.concatenate([t, jnp.cos(fr * w), -jnp.sin(fr * w)], axis=-1)
    freq = ffreq.astype(f32)
    hdn = jnp.sin(freq * (z @ fw1.astype(f32) + fb1.astype(f32)))
    hdn = jnp.sin(freq * (hdn @ fw2.astype(f32) + fb2.astype(f32)))
    h = (hdn @ fw3.astype(f32) + fb3.astype(f32)).reshape(L, HYENA_ORDER, 2, D_HYENA)
    deltas = jnp.abs(jnp.linspace(math.log(FILTER_TARGET) / SLOW_DECAY_PCT,
                                  math.log(FILTER_TARGET) / FAST_DECAY_PCT, D_HYENA, dtype=f32))
    h = h * jnp.exp(-t * deltas)[:, None, None, :]
    h_fwd, h_bwd = h[:, :, 0], h[:, :, 1]
    circ = jnp.concatenate([h_fwd, jnp.zeros((1, HYENA_ORDER, D_HYENA), f32), h_bwd[:0:-1]], axis=0)
    return jnp.fft.rfft(circ, axis=0)


def fftconv(u, hk, dbias):
    L = u.shape[1]
    uf = u.astype(jnp.float32)
    y = jnp.fft.irfft(jnp.fft.rfft(uf, n=2 * L, axis=1) * hk[None], n=2 * L, axis=1)[:, :L]
    return (y + uf * dbias.astype(jnp.float32)).astype(u.dtype)


def hyena_branch(u, conv_w, conv_b, fw1, fb1, fw2, fb2, fw3, fb3, ffreq, dbias):
    L = u.shape[1]
    u = short_conv(u, conv_w, conv_b)
    parts = jnp.split(u, HYENA_ORDER + 1, axis=-1)
    hk = hyena_filters(L, fw1, fb1, fw2, fb2, fw3, fb3, ffreq)
    z = parts[0]
    for n in range(HYENA_ORDER):
        z = parts[n + 1] * fftconv(z, hk[:, n], dbias[n])
    return z


def _rotate(x, pos):
    half = x.shape[-1] // 2
    inv = ROPE_BASE ** (-jnp.arange(half, dtype=jnp.float32) / half)
    ang = pos.astype(jnp.float32)[:, None] * inv[None, :]
    cos = jnp.cos(ang)[None, :, None, None, :].astype(x.dtype)
    sin = jnp.sin(ang)[None, :, None, None, :].astype(x.dtype)
    x1, x2 = x[..., :half], x[..., half:]
    return jnp.concatenate([x1 * cos - x2 * sin, x1 * sin + x2 * cos], axis=-1)


def rope_2d(x, row, col):
    h = x.shape[-1] // 2
    return jnp.concatenate([_rotate(x[..., :h], row), _rotate(x[..., h:], col)], axis=-1)


def diff_attention(q, k, v, lam):
    B, H, _, Lq, d = q.shape
    nb = Lq // Q_BLOCK
    qb = jnp.moveaxis(q.reshape(B, H, 2, nb, Q_BLOCK, d), 3, 0)
    scale = HEAD_DIM ** -0.5

    def block(qi):
        s = jnp.einsum('bhiqd,bhikd->bhiqk', qi, k).astype(jnp.float32) * scale
        p = jax.nn.softmax(s, axis=-1)
        a = (p[:, :, 0] - lam * p[:, :, 1]).astype(v.dtype)
        return jnp.einsum('bhqk,bhkv->bhqv', a, v)

    o = lax.map(block, qb)
    return jnp.moveaxis(o, 0, 2).reshape(B, H, Lq, 2 * d)


def heads_out(o, subln_g, lam_init):
    B, H, L, dv = o.shape
    o = rmsnorm(o, subln_g) * (1.0 - lam_init)
    return o.transpose(0, 2, 1, 3).reshape(B, L, H * dv)


def swiglu(h, w_gate, w_up, w_down):
    return (jax.nn.silu(h @ w_gate) * (h @ w_up)) @ w_down


def setup_inputs(seed: int = 0) -> dict:
    key = jax.random.key(seed)
    ks = jax.random.split(key, 40)
    f32 = jnp.float32

    def nrm(i, shape, s):
        return jax.random.normal(ks[i], shape, f32) * s

    return {
        'x': nrm(0, (BATCH, SEQ, D_MODEL), 1.0),
        'c': nrm(1, (BATCH, D_MODEL), 1.0),
        'ctx': nrm(2, (BATCH, CTX_LEN, D_MODEL), 1.0),
        'c_ctx': nrm(3, (D_MODEL,), 1.0),
        'w_ada': nrm(4, (DEPTH, D_MODEL, 6 * D_MODEL), 0.5 * D_MODEL ** -0.5),
        'b_ada': nrm(5, (DEPTH, 6 * D_MODEL), 0.01),
        'g_mix_pre': 1.0 + nrm(6, (DEPTH, D_MODEL), 0.05),
        'g_mix_post': 1.0 + nrm(7, (DEPTH, D_MODEL), 0.05),
        'g_ffn_pre': 1.0 + nrm(8, (DEPTH, D_MODEL), 0.05),
        'g_ffn_post': 1.0 + nrm(9, (DEPTH, D_MODEL), 0.05),
        'w_in': nrm(10, (DEPTH, D_MODEL, N_COLS), D_MODEL ** -0.5),
        'hy_conv_w': nrm(11, (DEPTH, 3, (HYENA_ORDER + 1) * D_HYENA), 0.5),
        'hy_conv_b': nrm(12, (DEPTH, (HYENA_ORDER + 1) * D_HYENA), 0.01),
        'hy_f_w1': nrm(13, (DEPTH, FILTER_EMB, FILTER_WIDTH), FILTER_EMB ** -0.5),
        'hy_f_b1': nrm(14, (DEPTH, FILTER_WIDTH), 0.1),
        'hy_f_w2': nrm(15, (DEPTH, FILTER_WIDTH, FILTER_WIDTH), FILTER_WIDTH ** -0.5),
        'hy_f_b2': nrm(16, (DEPTH, FILTER_WIDTH), 0.1),
        'hy_f_w3': nrm(17, (DEPTH, FILTER_WIDTH, HYENA_ORDER * 2 * D_HYENA), 0.03 * FILTER_WIDTH ** -0.5),
        'hy_f_b3': nrm(18, (DEPTH, HYENA_ORDER * 2 * D_HYENA), 0.003),
        'hy_f_freq': 1.0 + nrm(19, (DEPTH, FILTER_WIDTH), 0.05),
        'hy_bias': nrm(20, (DEPTH, HYENA_ORDER, D_HYENA), 1.0),
        'lambda_q1': nrm(21, (DEPTH, HEAD_DIM), 0.1),
        'lambda_k1': nrm(22, (DEPTH, HEAD_DIM), 0.1),
        'lambda_q2': nrm(23, (DEPTH, HEAD_DIM), 0.1),
        'lambda_k2': nrm(24, (DEPTH, HEAD_DIM), 0.1),
        'att_subln_g': 1.0 + nrm(25, (DEPTH, 2 * HEAD_DIM), 0.05),
        'w_hy_up': nrm(26, (DEPTH, D_HYENA, D_MODEL), D_HYENA ** -0.5),
        'w_att_up': nrm(27, (DEPTH, D_ATTN, D_MODEL), D_ATTN ** -0.5),
        'w_out': nrm(28, (DEPTH, D_MODEL, D_MODEL), D_MODEL ** -0.5),
        'w_ffn_gate': nrm(29, (DEPTH, D_MODEL, D_FF), D_MODEL ** -0.5),
        'w_ffn_up': nrm(30, (DEPTH, D_MODEL, D_FF), D_MODEL ** -0.5),
        'w_ffn_down': nrm(31, (DEPTH, D_FF, D_MODEL), D_FF ** -0.5),
    }


def reference(x, c, ctx, c_ctx, w_ada, b_ada, g_mix_pre, g_mix_post, g_ffn_pre, g_ffn_post,
              w_in, hy_conv_w, hy_conv_b, hy_f_w1, hy_f_b1, hy_f_w2, hy_f_b2, hy_f_w3, hy_f_b3,
              hy_f_freq, hy_bias, lambda_q1, lambda_k1, lambda_q2, lambda_k2, att_subln_g,
              w_hy_up, w_att_up, w_out, w_ffn_gate, w_ffn_up, w_ffn_down):
    B, L, D = x.shape
    C = ctx.shape[1]
    rows = L // GRID_W
    row = jnp.repeat(jnp.arange(rows, dtype=jnp.int32), GRID_W)
    col = jnp.tile(jnp.arange(GRID_W, dtype=jnp.int32), rows)
    f32 = jnp.float32

    for layer in range(DEPTH):
        last = layer == DEPTH - 1
        hy_p = (hy_conv_w[layer], hy_conv_b[layer], hy_f_w1[layer], hy_f_b1[layer], hy_f_w2[layer],
                hy_f_b2[layer], hy_f_w3[layer], hy_f_b3[layer], hy_f_freq[layer], hy_bias[layer])
        ada = jax.nn.silu(c) @ w_ada[layer] + b_ada[layer]
        sh1, sc1, g1, sh2, sc2, g2 = jnp.split(ada[:, None, :], 6, axis=-1)
        ada_c = jax.nn.silu(c_ctx) @ w_ada[layer] + b_ada[layer]
        csh1, csc1, cg1, csh2, csc2, cg2 = jnp.split(ada_c, 6, axis=-1)

        lam_init = 0.8 - 0.6 * math.exp(-0.3 * layer)
        lam = (jnp.exp(jnp.sum(lambda_q1[layer].astype(f32) * lambda_k1[layer].astype(f32)))
               - jnp.exp(jnp.sum(lambda_q2[layer].astype(f32) * lambda_k2[layer].astype(f32))) + lam_init)

        hc = modulate(rmsnorm(ctx, g_mix_pre[layer]), csh1, csc1)
        if last:
            kv_c = hc @ w_in[layer][:, OFF_K:OFF_G]
        else:
            proj_c = hc @ w_in[layer]
            kv_c = proj_c[..., OFF_K:OFF_G]
        k_c = kv_c[..., :D_ATTN].reshape(B, C, N_HEADS, 2, HEAD_DIM)
        v_c = kv_c[..., D_ATTN:].reshape(B, C, N_HEADS, 2 * HEAD_DIM)

        h = modulate(rmsnorm(x, g_mix_pre[layer]), sh1, sc1)
        proj = h @ w_in[layer]
        y_hy = hyena_branch(proj[..., :OFF_Q], *hy_p) @ w_hy_up[layer]
        q = rope_2d(proj[..., OFF_Q:OFF_K].reshape(B, L, N_HEADS, 2, HEAD_DIM), row, col)
        k = rope_2d(proj[..., OFF_K:OFF_V].reshape(B, L, N_HEADS, 2, HEAD_DIM), row, col)
        v = proj[..., OFF_V:OFF_G].reshape(B, L, N_HEADS, 2 * HEAD_DIM)
        k_all = jnp.concatenate([k, k_c], axis=1).transpose(0, 2, 3, 1, 4)
        v_all = jnp.concatenate([v, v_c], axis=1).transpose(0, 2, 1, 3)
        o = diff_attention(q.transpose(0, 2, 3, 1, 4), k_all, v_all, lam)
        y_att = heads_out(o, att_subln_g[layer], lam_init) @ w_att_up[layer]
        g_hy, g_att = jnp.split(jax.nn.sigmoid(proj[..., OFF_G:]), 2, axis=-1)
        mixed = (g_hy * y_hy + g_att * y_att) @ w_out[layer]
        x = x + g1 * rmsnorm(mixed, g_mix_post[layer])
        hf = modulate(rmsnorm(x, g_ffn_pre[layer]), sh2, sc2)
        f = swiglu(hf, w_ffn_gate[layer], w_ffn_up[layer], w_ffn_down[layer])
        x = x + g2 * rmsnorm(f, g_ffn_post[layer])

        if not last:
            qc = proj_c[..., OFF_Q:OFF_K].reshape(B, C, N_HEADS, 2, HEAD_DIM).transpose(0, 2, 3, 1, 4)
            oc = diff_attention(qc, k_c.transpose(0, 2, 3, 1, 4), v_c.transpose(0, 2, 1, 3), lam)
            yc_att = heads_out(oc, att_subln_g[layer], lam_init) @ w_att_up[layer]
            yc_hy = hyena_branch(proj_c[..., :OFF_Q], *hy_p) @ w_hy_up[layer]
            gc_hy, gc_att = jnp.split(jax.nn.sigmoid(proj_c[..., OFF_G:]), 2, axis=-1)
            mixed_c = (gc_hy * yc_hy + gc_att * yc_att) @ w_out[layer]
            ctx = ctx + cg1 * rmsnorm(mixed_c, g_mix_post[layer])
            hfc = modulate(rmsnorm(ctx, g_ffn_pre[layer]), csh2, csc2)
            fc = swiglu(hfc, w_ffn_gate[layer], w_ffn_up[layer], w_ffn_down[layer])
            ctx = ctx + cg2 * rmsnorm(fc, g_ffn_post[layer])
    return x
```

```cpp
#include <hip/hip_runtime.h>
#include <hip/hip_cooperative_groups.h>
#include <cstdio>
#include <cstdint>
namespace cg = cooperative_groups;
#define N_LAUNCH 1
namespace pg8 {
#define PG8_LAS __attribute__((address_space(3)))
typedef unsigned short bf16_t;
typedef short bf16x8 __attribute__((ext_vector_type(8)));
typedef float f32x4 __attribute__((ext_vector_type(4)));
typedef unsigned u32x4 __attribute__((ext_vector_type(4)));
constexpr int BM = 256, BK = 64, HALF = 128, HTB = HALF * BK * 2  , STAGE_BYTES = 8 * HTB, NXCD = 8, WGM = 8;

__host__ __device__ __forceinline__ int lds_byte(int r, int c) { const int st = (r >> 4) * 2 + (c >> 5), rr = r & 15, cc = c & 31, ob = rr * 64 + cc * 2; return st * 1024 + (ob ^ (((ob >> 9) & 1) << 5)); }
__host__ __device__ __forceinline__ void stage_rc(int b, int& R, int& C) { const int st = b / 1024, sb = b % 1024, swz = sb ^ (((sb >> 9) & 1) << 5); R = (st >> 1) * 16 + swz / 64; C = (st & 1) * 32 + (swz % 64) / 2; }
__host__ __device__ __forceinline__ int perm32(int rho) { const int n = rho >> 4, i = rho & 15; return 8 * (i >> 2) + 4 * n + (i & 3); }

struct Unit { int pm, pn; int koff = 0, half = 0; };
struct Gemm { const bf16_t* A; const bf16_t* Bt; int M, N, K; int ld = 0; };

struct StaticOrder {
    int nM, nN, nwg, G, c;
    __host__ __device__ void init(int M, int N, int G_, int c_) { nM = M / BM; nN = N / BM; nwg = nM * nN; G = G_; c = c_; }
    __host__ __device__ bool next(int i, Unit& u) const {
        const long L = (long)i * G + c; if (L >= nwg) return false;
        int wgid = (int)L; { const int q = nwg / NXCD, r = nwg % NXCD, xcd = wgid % NXCD, off = wgid / NXCD; wgid = (xcd < r ? xcd * (q + 1) : r * (q + 1) + (xcd - r) * q) + off; }
        const int nig = WGM * nN, gid = wgid / nig, fm = gid * WGM, gsz = (nM - fm) < WGM ? (nM - fm) : WGM;
        u.pm = fm + ((wgid % nig) % gsz); u.pn = (wgid % nig) / gsz; return true;
    }
    __device__ __forceinline__ void a_ready(const Unit&) const {}
    __device__ __forceinline__ void done(const Unit&) const {}
};
__device__ __forceinline__ unsigned cvt_pk_bf16(float lo, float hi) { unsigned r; asm volatile("v_cvt_pk_bf16_f32 %0, %1, %2" : "=v"(r) : "v"(lo), "v"(hi)); return r; }
template <class Epi, class Sched, bool ALIGN_EPI = false, bool SP2 = false>
__device__ __forceinline__ void gemm_phase(PG8_LAS unsigned char* lds, const Gemm g, const Sched& S, const Epi& E) {
    const int tid = threadIdx.x, wid = __builtin_amdgcn_readfirstlane(tid >> 6), lane = tid & 63, wr = wid >> 2, wc = wid & 3, fr = lane & 15, fq = lane >> 4;
    const int K = g.ld ? g.ld : g.K, nt = g.K / BK;
    unsigned voffA[2], voffB[2];
#pragma unroll
    for (int i = 0; i < 2; ++i) { int R, C; stage_rc(tid * 16 + i * 8192, R, C); const int Rb = Epi::PERM ? ((R & ~31) + perm32(R & 31)) : R;
        voffA[i] = (unsigned)(R * K + C) * 2u; voffB[i] = (unsigned)(Rb * K + C) * 2u; }
    const size_t kstep = (size_t)(BK * 2);
    const size_t hstep = (size_t)HALF * K * 2;
    const size_t tstep = 2 * hstep;
    const unsigned ldsw = (unsigned)wid * 1024u;
    const int aoff = lds_byte(wr * 64 + fr, fq * 8), boff = lds_byte(wc * 32 + fr, fq * 8);
#define PG8_SA(b, h) (((b) * 2 + (h)) * HTB)
#define PG8_SB(b, h) ((4 + (b) * 2 + (h)) * HTB)
#define PG8_STAGE(bufoff, gbase, voff) do { _Pragma("unroll") for (int _i = 0; _i < 2; ++_i) \
        __builtin_amdgcn_global_load_lds((const unsigned*)((const char*)(gbase) + (voff)[_i]), (PG8_LAS unsigned*)(lds + (bufoff) + ldsw + _i * 8192), 16, 0, 0); } while (0)
#define PG8_LDA(dst, b, h) do { _Pragma("unroll") for (int m = 0; m < 4; ++m) _Pragma("unroll") for (int k = 0; k < 2; ++k) dst[m][k] = *(const PG8_LAS bf16x8*)(lds + PG8_SA(b, h) + aoff + m * 2048 + k * 1024); } while (0)
#define PG8_LDB(dst, b, h) do { _Pragma("unroll") for (int n = 0; n < 2; ++n) _Pragma("unroll") for (int k = 0; k < 2; ++k) dst[n][k] = *(const PG8_LAS bf16x8*)(lds + PG8_SB(b, h) + boff + n * 2048 + k * 1024); } while (0)
#define PG8_MMA(ai, bj, At, Bt) do { __builtin_amdgcn_s_setprio(1); _Pragma("unroll") for (int m = 0; m < 4; ++m) _Pragma("unroll") for (int n = 0; n < 2; ++n) _Pragma("unroll") for (int k = 0; k < 2; ++k) \
        acc[ai][bj][m][n] = __builtin_amdgcn_mfma_f32_16x16x32_bf16(Bt[n][k], At[m][k], acc[ai][bj][m][n], 0, 0, 0); __builtin_amdgcn_s_setprio(0); } while (0)
#define PG8_WAIT_V(n) asm volatile("s_waitcnt vmcnt(" #n ")" ::: "memory")
#define PG8_WAIT_L(n) asm volatile("s_waitcnt lgkmcnt(" #n ")" ::: "memory")
#define PG8_BAR __builtin_amdgcn_s_barrier()
#define PG8_SCHED __builtin_amdgcn_sched_barrier(0)
    Unit cur, nxt; int ui = 0;
    if (!S.next(0, cur)) return;
    f32x4 acc[2][2][4][2];
#pragma unroll
    for (int a = 0; a < 2; ++a)
#pragma unroll
        for (int b = 0; b < 2; ++b)
#pragma unroll
            for (int m = 0; m < 4; ++m)
#pragma unroll
                for (int n = 0; n < 2; ++n) acc[a][b][m][n] = (f32x4){0.f, 0.f, 0.f, 0.f};
    bf16x8 At[4][2], B0[2][2], B1[2][2];
    const char* cA = (const char*)g.A + (size_t)cur.pm * tstep + cur.koff; const char* cB = (const char*)g.Bt + (size_t)cur.pn * tstep + cur.koff;
    S.a_ready(cur);
    if constexpr (SP2) {
        PG8_STAGE(PG8_SB(0, 0), cB, voffB); PG8_STAGE(PG8_SB(0, 1), cB + hstep, voffB); PG8_STAGE(PG8_SA(0, 0), cA, voffA); PG8_STAGE(PG8_SA(0, 1), cA + hstep, voffA);
        if (wr == 1) PG8_BAR;
        PG8_WAIT_V(2); PG8_BAR;
        PG8_STAGE(PG8_SB(1, 0), cB + kstep, voffB); PG8_STAGE(PG8_SA(1, 0), cA + kstep, voffA); PG8_STAGE(PG8_SB(1, 1), cB + hstep + kstep, voffB);
        PG8_WAIT_V(6); PG8_BAR;
    } else {
        PG8_STAGE(PG8_SB(0, 0), cB, voffB); PG8_STAGE(PG8_SA(0, 0), cA, voffA); PG8_STAGE(PG8_SB(0, 1), cB + hstep, voffB); PG8_STAGE(PG8_SA(0, 1), cA + hstep, voffA);
        if (wr == 1) PG8_BAR;
        PG8_WAIT_V(4); PG8_BAR;
        PG8_STAGE(PG8_SB(1, 0), cB + kstep, voffB); PG8_STAGE(PG8_SA(1, 0), cA + kstep, voffA); PG8_STAGE(PG8_SB(1, 1), cB + hstep + kstep, voffB);
        PG8_WAIT_V(6); PG8_BAR;
    }
    for (;;) {
        const bool has_next = S.next(ui + 1, nxt);
        const char* nA = has_next ? (const char*)g.A + (size_t)nxt.pm * tstep + nxt.koff : cA; const char* nB = has_next ? (const char*)g.Bt + (size_t)nxt.pn * tstep + nxt.koff : cB;
        for (int t = 0; t < nt; t += 2) {
            const bool last = (t == nt - 2);
            const char* a1 = cA + (size_t)(t + 1) * kstep;
            const char* a2 = last ? nA : cA + (size_t)(t + 2) * kstep; const char* b2 = last ? nB : cB + (size_t)(t + 2) * kstep;
            const char* a3 = a2 + kstep; const char* b3 = b2 + kstep;
            if (last && has_next) S.a_ready(nxt);
            if constexpr (SP2) {
            PG8_LDB(B0, 0, 0); PG8_LDB(B1, 0, 1); PG8_SCHED; PG8_LDA(At, 0, 0); PG8_STAGE(PG8_SA(1, 1), a1 + hstep, voffA);
            PG8_WAIT_V(8); PG8_WAIT_L(0); PG8_BAR; PG8_MMA(0, 0, At, B0); PG8_MMA(0, 1, At, B1); PG8_BAR; PG8_SCHED;
            PG8_LDA(At, 0, 1); PG8_STAGE(PG8_SB(0, 0), b2, voffB); PG8_STAGE(PG8_SB(0, 1), b2 + hstep, voffB); PG8_STAGE(PG8_SA(0, 0), a2, voffA);
            PG8_WAIT_V(8); PG8_WAIT_L(0); PG8_BAR; PG8_MMA(1, 0, At, B0); PG8_MMA(1, 1, At, B1); PG8_BAR; PG8_SCHED;
            PG8_LDB(B0, 1, 0); PG8_LDB(B1, 1, 1); PG8_SCHED; PG8_LDA(At, 1, 0); PG8_STAGE(PG8_SA(0, 1), a2 + hstep, voffA);
            PG8_WAIT_V(8); PG8_WAIT_L(0); PG8_BAR; PG8_MMA(0, 0, At, B0); PG8_MMA(0, 1, At, B1); PG8_BAR; PG8_SCHED;
            PG8_LDA(At, 1, 1); PG8_STAGE(PG8_SB(1, 0), b3, voffB); PG8_STAGE(PG8_SB(1, 1), b3 + hstep, voffB); PG8_STAGE(PG8_SA(1, 0), a3, voffA);
            PG8_WAIT_V(8); PG8_WAIT_L(0); PG8_BAR; PG8_MMA(1, 0, At, B0); PG8_MMA(1, 1, At, B1); PG8_BAR; PG8_SCHED;
            } else {
            PG8_LDB(B0, 0, 0); PG8_SCHED; PG8_LDA(At, 0, 0); PG8_STAGE(PG8_SA(1, 1), a1 + hstep, voffA);
            PG8_WAIT_L(8); PG8_BAR; PG8_WAIT_L(0); PG8_MMA(0, 0, At, B0); PG8_BAR; PG8_SCHED;
            PG8_LDB(B1, 0, 1); PG8_STAGE(PG8_SB(0, 0), b2, voffB);
            PG8_BAR; PG8_WAIT_L(0); PG8_MMA(0, 1, At, B1); PG8_BAR;
            PG8_LDA(At, 0, 1); PG8_STAGE(PG8_SA(0, 0), a2, voffA);
            PG8_BAR; PG8_WAIT_L(0); PG8_MMA(1, 0, At, B0); PG8_BAR; PG8_SCHED;
            PG8_STAGE(PG8_SB(0, 1), b2 + hstep, voffB);
            PG8_WAIT_V(6); PG8_BAR; PG8_MMA(1, 1, At, B1); PG8_BAR;
            PG8_LDB(B0, 1, 0); PG8_SCHED; PG8_LDA(At, 1, 0); PG8_STAGE(PG8_SA(0, 1), a2 + hstep, voffA);
            PG8_WAIT_L(8); PG8_BAR; PG8_WAIT_L(0); PG8_MMA(0, 0, At, B0); PG8_BAR; PG8_SCHED;
            PG8_LDB(B1, 1, 1); PG8_STAGE(PG8_SB(1, 0), b3, voffB);
            PG8_BAR; PG8_WAIT_L(0); PG8_MMA(0, 1, At, B1); PG8_BAR;
            PG8_LDA(At, 1, 1); PG8_STAGE(PG8_SA(1, 0), a3, voffA);
            PG8_BAR; PG8_WAIT_L(0); PG8_MMA(1, 0, At, B0); PG8_BAR; PG8_SCHED;
            PG8_STAGE(PG8_SB(1, 1), b3 + hstep, voffB);
            PG8_WAIT_V(6); PG8_BAR; PG8_MMA(1, 1, At, B1); PG8_BAR;
            }
        }
        if constexpr (ALIGN_EPI) { if (wr == 0) PG8_BAR; }
        if constexpr (!Epi::AFTER_DRAIN) { E(acc, cur, wr, wc, fr, fq); S.done(cur); }
        if (!has_next) break;
        if (E.zero_after(cur))
#pragma unroll
        for (int a = 0; a < 2; ++a)
#pragma unroll
            for (int b = 0; b < 2; ++b)
#pragma unroll
                for (int m = 0; m < 4; ++m)
#pragma unroll
                    for (int n = 0; n < 2; ++n) acc[a][b][m][n] = (f32x4){0.f, 0.f, 0.f, 0.f};
        cur = nxt; cA = nA; cB = nB; ++ui;
        if constexpr (ALIGN_EPI) { if (wr == 1) PG8_BAR; }
    }
    PG8_WAIT_V(0);
    if constexpr (!ALIGN_EPI) { if (wr == 0) PG8_BAR; }
    PG8_BAR;
    if constexpr (Epi::AFTER_DRAIN) { E.fused(acc, cur, wr, wc, fr, fq, lds, wid, lane); S.done(cur); }
#undef PG8_SA
#undef PG8_SB
#undef PG8_STAGE
#undef PG8_LDA
#undef PG8_LDB
#undef PG8_MMA
#undef PG8_WAIT_V
#undef PG8_WAIT_L
#undef PG8_BAR
#undef PG8_SCHED
}
}

#ifndef N_LAUNCH
#define N_LAUNCH 1
#endif
#ifndef AT_SGB
#define AT_SGB 1
#endif
#ifndef AT_VARIANT
#define AT_VARIANT 1
#endif
#ifndef PROBE_HY
#define PROBE_HY 1
#endif
#ifndef PROBE_AT
#define PROBE_AT 1
#endif
#ifndef PROBE_P2
#define PROBE_P2 1
#endif
#ifndef PROBE_P7
#define PROBE_P7 1
#endif
#define LAS __attribute__((address_space(3)))
#define DI __device__ __forceinline__
typedef unsigned char uchar;
using pg8::bf16_t; using pg8::bf16x8; using pg8::f32x4;
typedef float f32x16 __attribute__((ext_vector_type(16)));
typedef short s16x4 __attribute__((ext_vector_type(4)));
typedef float f32x2_t __attribute__((ext_vector_type(2)));
typedef __bf16 bf16x2_t __attribute__((ext_vector_type(2)));

constexpr int DM = 1024, NB = 8, SEQ = 4096, NTOK = NB * SEQ, CTXL = 256, NCTX = NB * CTXL, LKV = SEQ + CTXL;
constexpr int DHY = 512, NCOLS = 5120, DFF = 2816, NGU = 2 * DFF;
constexpr float EPSN = 1e-6f;
constexpr int LDS_BYTES = 131072 + 64;
constexpr int NPH = 10;

constexpr size_t al256(size_t x) { return (x + 255) & ~(size_t)255; }
constexpr size_t WS_WIN = 0;
constexpr size_t WS_WHY = WS_WIN + (size_t)NCOLS * DM * 2;
constexpr size_t WS_WATT = WS_WHY + (size_t)DM * DHY * 2;
constexpr size_t WS_WOUT = WS_WATT + (size_t)DM * DHY * 2;
constexpr size_t WS_WGU = WS_WOUT + (size_t)DM * DM * 2;
constexpr size_t WS_WDN = WS_WGU + (size_t)NGU * DM * 2;
constexpr size_t WS_R = WS_WDN + (size_t)DM * DFF * 2;
constexpr size_t WS_ADA = WS_R + (size_t)2 * DHY * 8192 * 2;
constexpr size_t WS_ROPE = al256(WS_ADA + (size_t)9 * 6144 * 4);
constexpr size_t WS_MISC = WS_ROPE + 64 * 32 * 4;
constexpr size_t WS_BAR = WS_MISC + 256;
constexpr size_t WS_SSQ = WS_BAR + 14336;
constexpr size_t WS_HC = WS_SSQ + (size_t)2 * NTOK * 4;
constexpr size_t WS_A = WS_HC + (size_t)NCTX * DM * 2;
constexpr size_t WS_B = WS_A + (size_t)NTOK * DM * 2;
constexpr size_t WS_UT = WS_B;
constexpr size_t WS_Q = WS_UT + (size_t)NB * 1536 * SEQ * 2;
constexpr size_t WS_K = WS_Q + (size_t)NTOK * 512 * 2;
constexpr size_t WS_V = WS_K + (size_t)NB * LKV * 512 * 2;
constexpr size_t WS_BEND = WS_V + (size_t)NB * LKV * 512 * 2;
constexpr size_t WS_C = WS_BEND;
constexpr size_t WS_D = WS_C + (size_t)NTOK * 2048 * 2;
constexpr size_t WS_END = WS_D + (size_t)2 * NTOK * 512 * 2;
static_assert((size_t)NTOK * DFF * 2 <= WS_BEND - WS_B, "ACT must fit region B");
static_assert(WS_END <= (size_t)536870912, "workspace map exceeds 512 MiB");

struct Params {
    const float *x, *c, *ctx, *c_ctx, *w_ada, *b_ada, *g_mix_pre, *g_mix_post, *g_ffn_pre, *g_ffn_post,
        *w_in, *hy_conv_w, *hy_conv_b, *f_w1, *f_b1, *f_w2, *f_b2, *f_w3, *f_b3, *f_freq, *hy_bias,
        *lq1, *lk1, *lq2, *lk2, *subln_g, *w_hy_up, *w_att_up, *w_out, *w_gate, *w_up, *w_down;
    float* out; unsigned char* ws; int ph_lo, ph_hi;
};

DI float bf2f(unsigned v) { return __uint_as_float(v << 16); }
DI unsigned pk2(float lo, float hi) { f32x2_t v = {lo, hi}; bf16x2_t b = __builtin_convertvector(v, bf16x2_t); return __builtin_bit_cast(unsigned, b); }
DI bf16_t f2bf(float x) { return (bf16_t)(pk2(x, 0.f) & 0xffffu); }
DI int crow(int r, int hi) { return (r & 3) + 8 * (r >> 2) + 4 * hi; }
DI float wave_sum(float v) {
#pragma unroll
    for (int o = 32; o > 0; o >>= 1) v += __shfl_xor(v, o);
    return v;
}
#define MFMA32(a, b, c) __builtin_amdgcn_mfma_f32_32x32x16_bf16((a), (b), (c), 0, 0, 0)
typedef short v4i16_t __attribute__((ext_vector_type(4)));
DI s16x4 vtr(LAS const uchar* p) { return __builtin_bit_cast(s16x4, __builtin_amdgcn_ds_read_tr16_b64_v4i16((LAS v4i16_t*)p)); }
DI bf16x8 pack8(const f32x16& x, int s) {
    typedef unsigned u32x4_t __attribute__((ext_vector_type(4)));
    u32x4_t p;
    if (s == 0) { p[0] = pk2(x[0], x[1]); p[1] = pk2(x[2], x[3]); p[2] = pk2(x[4], x[5]); p[3] = pk2(x[6], x[7]); }
    else        { p[0] = pk2(x[8], x[9]); p[1] = pk2(x[10], x[11]); p[2] = pk2(x[12], x[13]); p[3] = pk2(x[14], x[15]); }
    return __builtin_bit_cast(bf16x8, p);
}

#define EPI_ARGS const f32x4 (&acc)[2][2][4][2], const pg8::Unit& u, int wr, int wc, int fr, int fq
typedef unsigned u32x4v __attribute__((ext_vector_type(4)));
typedef unsigned u32x2v __attribute__((ext_vector_type(2)));

DI int win_colmap(int n) {
    if (n < 1536 || n >= 2560) return n;
    const int p = n & 31, a = p >> 3, bb = p & 7;
    const int orig = (bb < 4) ? 4 * a + bb : 16 + 4 * a + (bb - 4);
    return (n & ~31) + orig;
}

struct EpiIn {
    static constexpr bool PERM = true, AFTER_DRAIN = false;
    DI bool zero_after(const pg8::Unit&) const { return true; }
    bf16_t *UT, *Q, *K, *V, *G; const float* rope;
    DI void operator()(EPI_ARGS) const {
        const int row0 = u.pm * 256 + wr * 64 + fr;
        const int cb = u.pn * 256 + wc * 32 + 8 * fq;
        const int b = row0 >> 12, t0 = row0 & 4095;
        if (u.pn < 6) {
            const bool odd = fr & 1;
#pragma unroll
            for (int ai = 0; ai < 2; ++ai)
#pragma unroll
                for (int m = 0; m < 4; ++m) {
                    const int t = (t0 + ai * 128 + m * 16) & ~1;
#pragma unroll
                    for (int bj = 0; bj < 2; ++bj)
#pragma unroll
                        for (int n = 0; n < 2; ++n)
#pragma unroll
                            for (int jp = 0; jp < 2; ++jp) {
                                const float a0 = acc[ai][bj][m][n][2 * jp], a1 = acc[ai][bj][m][n][2 * jp + 1];
                                const float rcv = __shfl_xor(odd ? a0 : a1, 1);
                                const unsigned w = odd ? pk2(rcv, a1) : pk2(a0, rcv);
                                const int c = cb + bj * 128 + 4 * n + 2 * jp + (odd ? 1 : 0);
                                *(unsigned*)(UT + ((size_t)(b * 1536 + c) << 12) + t) = w;
                            }
                }
        } else if (u.pn < 10) {
            const bool isq = u.pn < 8;
            const float sc = isq ? 0.18033688011112042f : 1.0f;
#pragma unroll
            for (int ai = 0; ai < 2; ++ai)
#pragma unroll
                for (int m = 0; m < 4; ++m) {
                    const int t = t0 + ai * 128 + m * 16;
                    const int pos = (wc & 1) ? (t & 63) : (t >> 6);
                    const f32x4 cs = *(const f32x4*)(rope + pos * 32 + 4 * fq);
                    const f32x4 sn = *(const f32x4*)(rope + pos * 32 + 16 + 4 * fq);
#pragma unroll
                    for (int bj = 0; bj < 2; ++bj) {
                        const f32x4 x1 = acc[ai][bj][m][0], x2 = acc[ai][bj][m][1];
                        const f32x4 o1 = (x1 * cs - x2 * sn) * sc, o2 = (x1 * sn + x2 * cs) * sc;
                        u32x4v w; w.x = pk2(o1[0], o1[1]); w.y = pk2(o1[2], o1[3]); w.z = pk2(o2[0], o2[1]); w.w = pk2(o2[2], o2[3]);
                        const int c = cb + bj * 128;
                        if (isq) *(u32x4v*)(Q + (size_t)(b * 4096 + t) * 512 + (c - 1536)) = w;
                        else     *(u32x4v*)(K + (size_t)(b * LKV + t) * 512 + (c - 2048)) = w;
                    }
                }
        } else if (u.pn < 12) {
#pragma unroll
            for (int ai = 0; ai < 2; ++ai)
#pragma unroll
                for (int m = 0; m < 4; ++m) {
                    const int t = t0 + ai * 128 + m * 16;
#pragma unroll
                    for (int bj = 0; bj < 2; ++bj) {
                        const f32x4 a0 = acc[ai][bj][m][0], a1 = acc[ai][bj][m][1];
                        u32x4v w; w.x = pk2(a0[0], a0[1]); w.y = pk2(a0[2], a0[3]); w.z = pk2(a1[0], a1[1]); w.w = pk2(a1[2], a1[3]);
                        *(u32x4v*)(V + (size_t)(b * LKV + t) * 512 + (cb + bj * 128 - 2560)) = w;
                    }
                }
        } else {
#pragma unroll
            for (int ai = 0; ai < 2; ++ai)
#pragma unroll
                for (int m = 0; m < 4; ++m) {
                    const int row = row0 + ai * 128 + m * 16;
#pragma unroll
                    for (int bj = 0; bj < 2; ++bj) {
                        float s[8];
#pragma unroll
                        for (int n = 0; n < 2; ++n)
#pragma unroll
                            for (int j = 0; j < 4; ++j) s[4 * n + j] = __builtin_amdgcn_rcpf(1.0f + __builtin_amdgcn_exp2f(-1.4426950408889634f * acc[ai][bj][m][n][j]));
                        u32x4v w; w.x = pk2(s[0], s[1]); w.y = pk2(s[2], s[3]); w.z = pk2(s[4], s[5]); w.w = pk2(s[6], s[7]);
                        *(u32x4v*)(G + (size_t)row * 2048 + (cb + bj * 128 - 3072)) = w;
                    }
                }
        }
    }
};

struct EpiCtx {
    static constexpr bool PERM = true, AFTER_DRAIN = false;
    DI bool zero_after(const pg8::Unit&) const { return true; }
    bf16_t *K, *V;
    DI void operator()(EPI_ARGS) const {
        const int row0 = u.pm * 256 + wr * 64 + fr;
        const int cb = u.pn * 256 + wc * 32 + 8 * fq;
#pragma unroll
        for (int ai = 0; ai < 2; ++ai)
#pragma unroll
            for (int m = 0; m < 4; ++m) {
                const int row = row0 + ai * 128 + m * 16, b = row >> 8, tc = row & 255;
#pragma unroll
                for (int bj = 0; bj < 2; ++bj) {
                    const f32x4 a0 = acc[ai][bj][m][0], a1 = acc[ai][bj][m][1];
                    u32x4v w; w.x = pk2(a0[0], a0[1]); w.y = pk2(a0[2], a0[3]); w.z = pk2(a1[0], a1[1]); w.w = pk2(a1[2], a1[3]);
                    const int c = cb + bj * 128;
                    bf16_t* dst = (u.pn < 2) ? K + (size_t)(b * LKV + SEQ + tc) * 512 + c : V + (size_t)(b * LKV + SEQ + tc) * 512 + (c - 512);
                    *(u32x4v*)dst = w;
                }
            }
    }
};

struct EpiUpM {
    static constexpr bool PERM = true, AFTER_DRAIN = false;
    const bf16_t* G; bf16_t* O;
    DI bool zero_after(const pg8::Unit& u) const { return u.half != 0; }
    DI void mid(f32x4 (&acc)[2][2][4][2], const pg8::Unit& u, int wr, int wc, int fr, int fq) const {
        const int row0 = u.pm * 256 + wr * 64 + fr;
        const int cb = u.pn * 256 + wc * 32 + 8 * fq;
#pragma unroll
        for (int ai = 0; ai < 2; ++ai)
#pragma unroll
            for (int m = 0; m < 4; ++m) {
                const int row = row0 + ai * 128 + m * 16;
#pragma unroll
                for (int bj = 0; bj < 2; ++bj) {
                    const int c = cb + bj * 128;
                    const u32x4v gh = *(const u32x4v*)(G + (size_t)row * 2048 + c);
                    const u32x4v ga = *(const u32x4v*)(G + (size_t)row * 2048 + 1024 + c);
#pragma unroll
                    for (int q = 0; q < 4; ++q) {
                        const float r0 = bf2f(gh[q] & 0xffffu) * __builtin_amdgcn_rcpf(fmaxf(bf2f(ga[q] & 0xffffu), 1e-30f));
                        const float r1 = bf2f(gh[q] >> 16) * __builtin_amdgcn_rcpf(fmaxf(bf2f(ga[q] >> 16), 1e-30f));
                        acc[ai][bj][m][q >> 1][(q & 1) * 2] *= r0; acc[ai][bj][m][q >> 1][(q & 1) * 2 + 1] *= r1;
                    }
                    asm volatile("" : "+v"(acc[ai][bj][m][0]), "+v"(acc[ai][bj][m][1]) :: "memory");
                }
            }
    }
    DI void operator()(EPI_ARGS) const {
        if (u.half == 0) { mid(const_cast<f32x4 (&)[2][2][4][2]>(acc), u, wr, wc, fr, fq); return; }
        const int row0 = u.pm * 256 + wr * 64 + fr;
        const int cb = u.pn * 256 + wc * 32 + 8 * fq;
#pragma unroll
        for (int ai = 0; ai < 2; ++ai)
#pragma unroll
            for (int m = 0; m < 4; ++m) {
                const int row = row0 + ai * 128 + m * 16;
#pragma unroll
                for (int bj = 0; bj < 2; ++bj) {
                    const int c = cb + bj * 128;
                    const u32x4v ga = *(const u32x4v*)(G + (size_t)row * 2048 + 1024 + c);
                    u32x4v w;
#pragma unroll
                    for (int q = 0; q < 4; ++q)
                        w[q] = pk2(acc[ai][bj][m][q >> 1][(q & 1) * 2] * bf2f(ga[q] & 0xffffu), acc[ai][bj][m][q >> 1][(q & 1) * 2 + 1] * bf2f(ga[q] >> 16));
                    *(u32x4v*)(O + (size_t)row * 1024 + c) = w;
                }
            }
    }
};

struct EpiSsq {
    static constexpr bool PERM = true, AFTER_DRAIN = false;
    DI bool zero_after(const pg8::Unit&) const { return true; }
    bf16_t* O; float* ssq;
    DI void operator()(EPI_ARGS) const {
        const int row0 = u.pm * 256 + wr * 64 + fr;
        const int cb = u.pn * 256 + wc * 32 + 8 * fq;
#pragma unroll
        for (int ai = 0; ai < 2; ++ai)
#pragma unroll
            for (int m = 0; m < 4; ++m) {
                const int row = row0 + ai * 128 + m * 16;
                float ss = 0.f;
#pragma unroll
                for (int bj = 0; bj < 2; ++bj) {
                    const f32x4 a0 = acc[ai][bj][m][0], a1 = acc[ai][bj][m][1];
                    ss += a0[0] * a0[0] + a0[1] * a0[1] + a0[2] * a0[2] + a0[3] * a0[3] + a1[0] * a1[0] + a1[1] * a1[1] + a1[2] * a1[2] + a1[3] * a1[3];
                    u32x4v w; w.x = pk2(a0[0], a0[1]); w.y = pk2(a0[2], a0[3]); w.z = pk2(a1[0], a1[1]); w.w = pk2(a1[2], a1[3]);
                    *(u32x4v*)(O + (size_t)row * 1024 + cb + bj * 128) = w;
                }
                ss += __shfl_xor(ss, 16); ss += __shfl_xor(ss, 32);
                if (fq == 0) atomicAdd(ssq + row, ss);
            }
    }
};

struct EpiGU {
    static constexpr bool PERM = true, AFTER_DRAIN = false;
    DI bool zero_after(const pg8::Unit&) const { return true; }
    bf16_t* ACT;
    DI void operator()(EPI_ARGS) const {
        const int row0 = u.pm * 256 + wr * 64 + fr;
        const int cb = u.pn * 128 + wc * 16 + 4 * fq;
#pragma unroll
        for (int ai = 0; ai < 2; ++ai)
#pragma unroll
            for (int m = 0; m < 4; ++m) {
                const int row = row0 + ai * 128 + m * 16;
#pragma unroll
                for (int bj = 0; bj < 2; ++bj) {
                    const f32x4 g = acc[ai][bj][m][0], up = acc[ai][bj][m][1];
                    float r[4];
#pragma unroll
                    for (int j = 0; j < 4; ++j) r[j] = g[j] * __builtin_amdgcn_rcpf(1.0f + __builtin_amdgcn_exp2f(-1.4426950408889634f * g[j])) * up[j];
                    u32x2v w; w.x = pk2(r[0], r[1]); w.y = pk2(r[2], r[3]);
                    *(u32x2v*)(ACT + (size_t)row * DFF + cb + bj * 64) = w;
                }
            }
    }
};

struct HalfOrder {
    pg8::StaticOrder base; int khalf_bytes;
    DI bool next(int i, pg8::Unit& u) const { if (!base.next(i >> 1, u)) return false; u.half = i & 1; u.koff = (i & 1) * khalf_bytes; return true; }
    DI void a_ready(const pg8::Unit&) const {}
    DI void done(const pg8::Unit&) const {}
};

DI void tconv_ld(const Params& P, int it, int tid, f32x4 (&v)[8], bf16_t*& dp, int& K) {
    uchar* ws = P.ws;
    const float* sp; size_t stride; bf16_t* D; int ct, kt, r4;
    const int cl = 4 * (tid & 63), kg = tid >> 6; int kdst = 0;
    if (it < 320) { ct = it >> 4; kt = it & 15; K = 1024; D = (bf16_t*)(ws + WS_WIN); sp = P.w_in; stride = NCOLS;
        const int c4 = ct * 256 + cl; if (c4 < 1536 || c4 >= 2560) r4 = c4; else { const int o = c4 & 31; r4 = (c4 & ~31) + (o < 16 ? 2 * o : 2 * (o - 16) + 4); } }
    else if (it < 352) { const int i2 = it - 320; ct = i2 >> 3; kt = i2 & 7; K = 1024; D = (bf16_t*)(ws + WS_WHY); sp = P.w_hy_up; stride = 1024; r4 = ct * 256 + cl; }
    else if (it < 384) { const int i2 = it - 352; ct = i2 >> 3; kt = i2 & 7; K = 1024; D = (bf16_t*)(ws + WS_WHY); sp = P.w_att_up; stride = 1024; r4 = ct * 256 + cl; kdst = 512; }
    else if (it < 448) { const int i2 = it - 384; ct = i2 >> 4; kt = i2 & 15; K = 1024; D = (bf16_t*)(ws + WS_WOUT); sp = P.w_out; stride = 1024; r4 = ct * 256 + cl; }
    else if (it < 624) { const int i2 = it - 448; ct = i2 >> 4; kt = i2 & 15; K = 1024; D = (bf16_t*)(ws + WS_WGU); sp = P.w_gate; stride = DFF; r4 = 2 * (ct * 256 + cl); }
    else if (it < 800) { const int i2 = it - 624; ct = i2 >> 4; kt = i2 & 15; K = 1024; D = (bf16_t*)(ws + WS_WGU); sp = P.w_up; stride = DFF; r4 = 2 * (ct * 256 + cl) + 4; }
    else { const int i2 = it - 800; ct = i2 / 44; kt = i2 % 44; K = DFF; D = (bf16_t*)(ws + WS_WDN); sp = P.w_down; stride = 1024; r4 = ct * 256 + cl; }
    const int k0 = kt * 64 + kg * 8;
    sp += (size_t)k0 * stride + ct * 256 + cl;
#pragma unroll
    for (int j = 0; j < 8; ++j) v[j] = *(const f32x4*)(sp + (size_t)j * stride);
    dp = D + (size_t)r4 * K + k0 + kdst;
}
DI void tconv_st(const f32x4 (&v)[8], bf16_t* dp, int K) {
#pragma unroll
    for (int q = 0; q < 4; ++q) {
        u32x4v w; w.x = pk2(v[0][q], v[1][q]); w.y = pk2(v[2][q], v[3][q]); w.z = pk2(v[4][q], v[5][q]); w.w = pk2(v[6][q], v[7][q]);
        *(u32x4v*)(dp + (size_t)q * K) = w;
    }
}

constexpr int NCOPY_EARLY = 320, NCOPY_ALL = 976;
DI void tconv_range(const Params& P, int tid, int lo, int hi, int worker, int nworkers) {
    for (int it = lo + worker; it < hi; it += 2 * nworkers) {
        f32x4 va[8], vb[8]; bf16_t *da, *db = nullptr; int Ka, Kb = 0;
        const bool hb = it + nworkers < hi;
        tconv_ld(P, it, tid, va, da, Ka);
        if (hb) tconv_ld(P, it + nworkers, tid, vb, db, Kb);
        tconv_st(va, da, Ka);
        if (hb) tconv_st(vb, db, Kb);
    }
}
DI void phase_prep(const Params& P, LAS uchar* lds) {
    const int tid = threadIdx.x, G = gridDim.x, bid = blockIdx.x;
    const int gtid = bid * 512 + tid, gsz = G * 512;
    uchar* ws = P.ws;
    tconv_range(P, tid, 0, NCOPY_EARLY, bid, G);
    {
        LAS float* sl = (LAS float*)lds;
        LAS float* part = sl + 9216;
        float* ada = (float*)(ws + WS_ADA);
        __syncthreads();
        for (int i = tid; i < 9216; i += 512) { const int r = i >> 10, k = i & 1023; const float v = r < 8 ? P.c[r * 1024 + k] : P.c_ctx[k]; sl[i] = v / (1.0f + expf(-v)); }
        __syncthreads();
        for (int cbk = bid; cbk < 256; cbk += G) {
            if (tid < 504) {
                const int col = tid % 24, kp = tid / 24;
                float a[9];
#pragma unroll
                for (int r = 0; r < 9; ++r) a[r] = 0.f;
#pragma unroll 7
                for (int k = kp; k < 1024; k += 21) {
                    const float w = P.w_ada[(size_t)k * 6144 + cbk * 24 + col];
#pragma unroll
                    for (int r = 0; r < 9; ++r) a[r] += sl[r * 1024 + k] * w;
                }
#pragma unroll
                for (int r = 0; r < 9; ++r) part[kp * 216 + r * 24 + col] = a[r];
            }
            __syncthreads();
            if (tid < 216) {
                float s = 0.f;
                for (int kp = 0; kp < 21; ++kp) s += part[kp * 216 + tid];
                const int r = tid / 24, col = tid % 24;
                ada[r * 6144 + cbk * 24 + col] = s + P.b_ada[cbk * 24 + col];
            }
            __syncthreads();
        }
    }
    {
        LAS float* zb = (LAS float*)lds;
        LAS float* h1 = zb + 17 * 33 + 3;
        LAS float* h2 = h1 + 17 * 64;
        bf16_t* R = (bf16_t*)(ws + WS_R);
        for (int pb = bid; pb < 256; pb += G) {
            const int t0 = pb * 16;
            int tl = tid; asm volatile("" : "+v"(tl));
            __syncthreads();
            if (tl < 272) {
                const int pp = tl >> 4, i = tl & 15, t = t0 + pp;
                const float w = (6.283185307179586f / 4096.0f) * (float)t;
                const float fr = 1e-4f + (float)i * ((15.0f - 1e-4f) / 15.0f);
                const float a = fr * w;
                zb[pp * 33 + 1 + i] = __cosf(a); zb[pp * 33 + 17 + i] = -__sinf(a);
                if (i == 0) zb[pp * 33] = (float)t * (1.0f / 4095.0f);
            }
            __syncthreads();
            for (int o = tl; o < 1088; o += 512) {
                const int pp = o >> 6, j = o & 63; float s = P.f_b1[j];
#pragma unroll
                for (int e = 0; e < 33; ++e) s += zb[pp * 33 + e] * P.f_w1[e * 64 + j];
                h1[o] = __sinf(P.f_freq[j] * s);
            }
            __syncthreads();
            for (int o = tl; o < 1088; o += 512) {
                const int pp = o >> 6, j = o & 63; float s = P.f_b2[j];
#pragma unroll 16
                for (int e = 0; e < 64; ++e) s += h1[pp * 64 + e] * P.f_w2[e * 64 + j];
                h2[o] = __sinf(P.f_freq[j] * s);
            }
            __syncthreads();
            const int col0 = tl * 4, n = col0 >> 10, dir = (col0 >> 9) & 1, off = dir ? 0 : 1;
            float acc[16][4];
#pragma unroll
            for (int pp = 0; pp < 16; ++pp)
#pragma unroll
                for (int j = 0; j < 4; ++j) acc[pp][j] = 0.f;
#pragma unroll 8
            for (int k = 0; k < 64; ++k) {
                const f32x4 w = *(const f32x4*)(P.f_w3 + (size_t)k * 2048 + col0);
#pragma unroll
                for (int pp = 0; pp < 16; ++pp) { const float hv = h2[(pp + off) * 64 + k];
#pragma unroll
                    for (int j = 0; j < 4; ++j) acc[pp][j] += hv * w[j]; }
            }
            LAS float* xch = h2 + 17 * 64;
            if (pb == 0) {
                if (dir == 0) {
                    float a0[4] = {0.f, 0.f, 0.f, 0.f};
#pragma unroll 2
                    for (int k = 0; k < 64; ++k) { const f32x4 w = *(const f32x4*)(P.f_w3 + (size_t)k * 2048 + col0); const float hv = h2[k];
#pragma unroll
                        for (int j = 0; j < 4; ++j) a0[j] += hv * w[j]; }
#pragma unroll
                    for (int j = 0; j < 4; ++j) xch[tl * 4 + j] = a0[j] + P.f_b3[col0 + j];
                }
                __syncthreads();
            }
            const float la = -3.0701134573253944f, lb = -15.350567286626973f;
#pragma unroll
            for (int j = 0; j < 4; ++j) {
                const int cch = (col0 + j) & 511;
                const float delta = fabsf(la + (lb - la) * ((float)cch / 511.0f));
                const float b3 = P.f_b3[col0 + j];
                bf16_t* Rc = R + ((size_t)(n * 512 + cch) << 13);
                float v[16];
                float dec = expf(-(float)(t0 + off) * (1.0f / 4095.0f) * delta); const float rr = expf(-delta * (1.0f / 4095.0f));
#pragma unroll
                for (int pp = 0; pp < 16; ++pp) { v[pp] = (acc[pp][j] + b3) * dec; dec *= rr; }
                if (dir == 0) {
                    if (pb == 255) v[15] = 0.f;
                    u32x4v w0, w1;
#pragma unroll
                    for (int i = 0; i < 4; ++i) { w0[i] = pk2(v[15 - 2 * i], v[14 - 2 * i]); w1[i] = pk2(v[7 - 2 * i], v[6 - 2 * i]); }
                    *(u32x4v*)(Rc + 4080 - t0) = w0; *(u32x4v*)(Rc + 4088 - t0) = w1;
                } else {
                    if (pb == 0) v[0] = xch[(tl - 128) * 4 + j];
                    u32x4v w0, w1;
#pragma unroll
                    for (int i = 0; i < 4; ++i) { w0[i] = pk2(v[2 * i], v[2 * i + 1]); w1[i] = pk2(v[8 + 2 * i], v[9 + 2 * i]); }
                    *(u32x4v*)(Rc + 4096 + t0) = w0; *(u32x4v*)(Rc + 4104 + t0) = w1;
                }
            }
        }
    }
    {
        float* rope = (float*)(ws + WS_ROPE);
        for (int i = gtid; i < 1024; i += gsz) {
            const int pos = i >> 4, f = i & 15;
            const float inv = powf(10000.0f, -(float)f / 16.0f), ang = (float)pos * inv;
            rope[pos * 32 + f] = cosf(ang); rope[pos * 32 + 16 + f] = sinf(ang);
        }
        if (gtid < 64) {
            float s1 = P.lq1[gtid] * P.lk1[gtid], s2 = P.lq2[gtid] * P.lk2[gtid];
            s1 = wave_sum(s1); s2 = wave_sum(s2);
            if (gtid == 0) ((float*)(ws + WS_MISC))[0] = expf(s1) - expf(s2) + 0.2f;
        }
        float* ssq = (float*)(ws + WS_SSQ);
        for (int i = gtid; i < 2 * NTOK; i += gsz) ssq[i] = 0.f;
    }
}

DI f32x4 ld_bf4(const bf16_t* p) { const u32x2v w = *(const u32x2v*)p; return (f32x4){bf2f(w.x & 0xffffu), bf2f(w.x >> 16), bf2f(w.y & 0xffffu), bf2f(w.y >> 16)}; }
DI void st_bf4(bf16_t* p, const f32x4 h) { u32x2v w; w.x = pk2(h[0], h[1]); w.y = pk2(h[2], h[3]); *(u32x2v*)p = w; }
DI float sq4(const f32x4 v) { return v[0] * v[0] + v[1] * v[1] + v[2] * v[2] + v[3] * v[3]; }
constexpr int RW = 4;
DI void phase_norm1(const Params& P) {
    const int lane = threadIdx.x & 63, gw = blockIdx.x * 8 + (threadIdx.x >> 6), nw = gridDim.x * 8;
    const float* ada = (const float*)(P.ws + WS_ADA);
    bf16_t* H = (bf16_t*)(P.ws + WS_A); bf16_t* HC = (bf16_t*)(P.ws + WS_HC);
    for (int row0 = gw * RW; row0 < NTOK + NCTX; row0 += nw * RW) {
        const bool lat = row0 < NTOK;
        const float* src = lat ? P.x + (size_t)row0 * 1024 : P.ctx + (size_t)(row0 - NTOK) * 1024;
        const float* ar = ada + (lat ? (row0 >> 12) : 8) * 6144;
        bf16_t* dst = lat ? H + (size_t)row0 * 1024 : HC + (size_t)(row0 - NTOK) * 1024;
        f32x4 v[RW][4]; float ss[RW];
#pragma unroll
        for (int r = 0; r < RW; ++r)
#pragma unroll
            for (int i = 0; i < 4; ++i) v[r][i] = __builtin_nontemporal_load((const f32x4*)(src + r * 1024 + i * 256 + lane * 4));
        f32x4 g[4], sh[4], sc[4];
#pragma unroll
        for (int i = 0; i < 4; ++i) { const int col = i * 256 + lane * 4; g[i] = *(const f32x4*)(P.g_mix_pre + col); sh[i] = *(const f32x4*)(ar + col); sc[i] = *(const f32x4*)(ar + 1024 + col); }
#pragma unroll
        for (int r = 0; r < RW; ++r) { ss[r] = sq4(v[r][0]) + sq4(v[r][1]) + sq4(v[r][2]) + sq4(v[r][3]); ss[r] = wave_sum(ss[r]); }
#pragma unroll
        for (int r = 0; r < RW; ++r) {
            const float rstd = rsqrtf(ss[r] * (1.0f / 1024.0f) + EPSN);
#pragma unroll
            for (int i = 0; i < 4; ++i) st_bf4(dst + r * 1024 + i * 256 + lane * 4, v[r][i] * rstd * g[i] * (sc[i] + 1.0f) + sh[i]);
        }
    }
}

DI void phase_mid(const Params& P) {
    const int lane = threadIdx.x & 63, gw = blockIdx.x * 8 + (threadIdx.x >> 6), nw = gridDim.x * 8;
    const float* ada = (const float*)(P.ws + WS_ADA);
    const bf16_t* MX = (const bf16_t*)(P.ws + WS_C); const float* ssq1 = (const float*)(P.ws + WS_SSQ);
    bf16_t* HF = (bf16_t*)(P.ws + WS_A);
    for (int row0 = gw * RW; row0 < NTOK; row0 += nw * RW) {
        const float* ar = ada + (row0 >> 12) * 6144;
        f32x4 v[RW][4], mv[RW][4]; float rs1[RW], ss[RW];
#pragma unroll
        for (int r = 0; r < RW; ++r) {
            rs1[r] = ssq1[row0 + r];
#pragma unroll
            for (int i = 0; i < 4; ++i) { const size_t o = (size_t)(row0 + r) * 1024 + i * 256 + lane * 4; v[r][i] = __builtin_nontemporal_load((const f32x4*)(P.x + o)); mv[r][i] = ld_bf4(MX + o); }
        }
#pragma unroll
        for (int r = 0; r < RW; ++r) {
            const float rstd1 = rsqrtf(rs1[r] * (1.0f / 1024.0f) + EPSN);
            ss[r] = 0.f;
#pragma unroll
            for (int i = 0; i < 4; ++i) {
                const int col = i * 256 + lane * 4;
                const f32x4 gp = *(const f32x4*)(P.g_mix_post + col), g1 = *(const f32x4*)(ar + 2048 + col);
                v[r][i] = v[r][i] + g1 * (mv[r][i] * rstd1 * gp);
                ss[r] += sq4(v[r][i]);
            }
            ss[r] = wave_sum(ss[r]);
        }
#pragma unroll
        for (int r = 0; r < RW; ++r) {
            const float rstd = rsqrtf(ss[r] * (1.0f / 1024.0f) + EPSN);
#pragma unroll
            for (int i = 0; i < 4; ++i) {
                const int col = i * 256 + lane * 4;
                const f32x4 g = *(const f32x4*)(P.g_ffn_pre + col), sh = *(const f32x4*)(ar + 3072 + col), sc = *(const f32x4*)(ar + 4096 + col);
                st_bf4(HF + (size_t)(row0 + r) * 1024 + col, v[r][i] * rstd * g * (sc + 1.0f) + sh);
            }
        }
    }
}

DI void phase_final(const Params& P) {
    constexpr int R9 = 2;
    const int lane = threadIdx.x & 63, gw = blockIdx.x * 8 + (threadIdx.x >> 6), nw = gridDim.x * 8;
    const float* ada = (const float*)(P.ws + WS_ADA);
    const bf16_t* MX = (const bf16_t*)(P.ws + WS_C); const bf16_t* F = (const bf16_t*)(P.ws + WS_C + (size_t)NTOK * 1024 * 2);
    const float* ssq1 = (const float*)(P.ws + WS_SSQ); const float* ssq2 = ssq1 + NTOK;
    for (int row0 = gw * R9; row0 < NTOK; row0 += nw * R9) {
        const float* ar = ada + (row0 >> 12) * 6144;
        f32x4 v[R9][4], mv[R9][4], fv[R9][4]; float rs1[R9], rs2[R9];
#pragma unroll
        for (int r = 0; r < R9; ++r) {
            rs1[r] = ssq1[row0 + r]; rs2[r] = ssq2[row0 + r];
#pragma unroll
            for (int i = 0; i < 4; ++i) { const size_t o = (size_t)(row0 + r) * 1024 + i * 256 + lane * 4; v[r][i] = __builtin_nontemporal_load((const f32x4*)(P.x + o)); mv[r][i] = ld_bf4(MX + o); fv[r][i] = ld_bf4(F + o); }
        }
#pragma unroll
        for (int r = 0; r < R9; ++r) {
            const float rstd1 = rsqrtf(rs1[r] * (1.0f / 1024.0f) + EPSN), rstd2 = rsqrtf(rs2[r] * (1.0f / 1024.0f) + EPSN);
#pragma unroll
            for (int i = 0; i < 4; ++i) {
                const int col = i * 256 + lane * 4;
                const f32x4 gp1 = *(const f32x4*)(P.g_mix_post + col), g1 = *(const f32x4*)(ar + 2048 + col);
                const f32x4 gp = *(const f32x4*)(P.g_ffn_post + col), g2 = *(const f32x4*)(ar + 5120 + col);
                const f32x4 x1 = v[r][i] + g1 * (mv[r][i] * rstd1 * gp1);
                __builtin_nontemporal_store(x1 + g2 * (fv[r][i] * rstd2 * gp), (f32x4*)(P.out + (size_t)(row0 + r) * 1024 + col));
            }
        }
    }
}

DI float xhalf_max(float m) { auto rr = __builtin_amdgcn_permlane32_swap(__float_as_uint(m), __float_as_uint(m), false, false); return fmaxf(__uint_as_float(rr[0]), __uint_as_float(rr[1])); }
DI float xhalf_sum(float m) { auto rr = __builtin_amdgcn_permlane32_swap(__float_as_uint(m), __float_as_uint(m), false, false); return __uint_as_float(rr[0]) + __uint_as_float(rr[1]); }
DI void glds16(const void* gsrc, unsigned lds_dst) { unsigned keep;
    asm volatile("s_mov_b32 %0, m0\n\ts_mov_b32 m0, %2\n\ts_nop 0\n\tglobal_load_lds_dwordx4 %1, off\n\ts_mov_b32 m0, %0" : "=&s"(keep) : "v"(gsrc), "s"(lds_dst) : "memory"); }
DI void attn_unit(const Params& P, LAS uchar* lds, int b, int h, int qb, float lam) {
    int tid_ = threadIdx.x; asm volatile("" : "+v"(tid_));
    const int tid = tid_, lane = tid & 63, wid = __builtin_amdgcn_readfirstlane(tid >> 6), map = wid >> 2, wq = wid & 3, r32 = lane & 31, hi = lane >> 5;
    const bf16_t* Qg = (const bf16_t*)(P.ws + WS_Q) + (size_t)(b * 4096 + qb * 128 + wq * 32 + r32) * 512 + h * 128 + map * 64 + hi * 8;
    bf16x8 qf[4];
#pragma unroll
    for (int s = 0; s < 4; ++s) qf[s] = *(const bf16x8*)(Qg + 16 * s);
    constexpr unsigned KS = 16384, VS0 = 2 * KS, VS = 16384;
    constexpr size_t TILE = (size_t)64 * 512;
    const bf16_t* kg[2]; const bf16_t* vg[2];
#pragma unroll
    for (int i = 0; i < 2; ++i) {
        const int j = 2 * wid + i;
        const int krow = 8 * (j & 7) + (lane >> 3), kc = (lane & 7) ^ ((krow >> 1) & 7);
        kg[i] = (const bf16_t*)(P.ws + WS_K) + (size_t)(b * LKV + krow) * 512 + h * 128 + (j >> 3) * 64 + kc * 8;
        const int vrow = 4 * j + (lane >> 4), vc = (lane & 15) ^ (4 * (vrow & 3));
        vg[i] = (const bf16_t*)(P.ws + WS_V) + (size_t)(b * LKV + vrow) * 512 + h * 128 + vc * 8;
    }
    const unsigned ldsw = (unsigned)wid * 2048u;
    const unsigned lds0 = (unsigned)(size_t)lds;
#define AT_DMA_K(T, SLOT) do { _Pragma("unroll") for (int i_ = 0; i_ < 2; ++i_) \
        glds16(kg[i_] + (size_t)(T) * TILE, (unsigned)__builtin_amdgcn_readfirstlane(lds0 + (SLOT) + ldsw + i_ * 1024)); } while (0)
#define AT_DMA_V(T, SLOT) do { _Pragma("unroll") for (int i_ = 0; i_ < 2; ++i_) \
        glds16(vg[i_] + (size_t)(T) * TILE, (unsigned)__builtin_amdgcn_readfirstlane(lds0 + (SLOT) + ldsw + i_ * 1024)); } while (0)
    unsigned kq[4], vq[4];
    { const int x = (r32 >> 1) & 7, q = (lane & 15) >> 2, p = lane & 3, blk = (lane >> 4) & 1;
#pragma unroll
      for (int s = 0; s < 4; ++s) kq[s] = map * 8192 + r32 * 128 + (((2 * s + hi) ^ x) << 4);
#pragma unroll
      for (int d = 0; d < 4; ++d) vq[d] = (4 * hi + q) * 256 + ((4 * (d ^ q) + 2 * blk + (p >> 1)) << 4) + 8 * (p & 1); }
#define AT_QK(KSLOT) do { _Pragma("unroll") for (int s = 0; s < 4; ++s) { \
        const bf16x8 a0 = *(LAS const bf16x8*)(lds + (KSLOT) + kq[s]); const bf16x8 a1 = *(LAS const bf16x8*)(lds + (KSLOT) + kq[s] + 4096); \
        if (s == 0) { st0 = MFMA32(a0, qf[0], negm); st1 = MFMA32(a1, qf[0], negm); } else { st0 = MFMA32(a0, qf[s], st0); st1 = MFMA32(a1, qf[s], st1); } } } while (0)
#define AT_PV(VSLOT) do { _Pragma("unroll") for (int ks = 0; ks < 4; ++ks) _Pragma("unroll") for (int d = 0; d < 4; ++d) { \
        const s16x4 lo = vtr(lds + (VSLOT) + vq[d] + (16 * ks) * 256); const s16x4 hh = vtr(lds + (VSLOT) + vq[d] + (16 * ks + 8) * 256); \
        const bf16x8 va = __builtin_shufflevector(lo, hh, 0, 1, 2, 3, 4, 5, 6, 7); ot[d] = MFMA32(va, pb[ks], ot[d]); } } while (0)
#define AT_ROWMAX(mx) do { float a_ = fmaxf(st0[0], st1[0]), b_ = fmaxf(st0[1], st1[1]); _Pragma("unroll") for (int r = 2; r < 16; r += 2) { a_ = fmaxf(a_, fmaxf(st0[r], st1[r])); b_ = fmaxf(b_, fmaxf(st0[r + 1], st1[r + 1])); } mx = xhalf_max(fmaxf(a_, b_)); } while (0)
#define AT_EXPS(PB) do { float s0_ = 0.f, s1_ = 0.f; _Pragma("unroll") for (int r = 0; r < 16; ++r) { st0[r] = __builtin_amdgcn_exp2f(st0[r]); st1[r] = __builtin_amdgcn_exp2f(st1[r]); s0_ += st0[r]; s1_ += st1[r]; } \
        lsum += s0_ + s1_; PB[0] = pack8(st0, 0); PB[1] = pack8(st0, 1); PB[2] = pack8(st1, 0); PB[3] = pack8(st1, 1); } while (0)
    __syncthreads();
    AT_DMA_K(0, 0); AT_DMA_K(1, KS); AT_DMA_V(0, VS0);
    asm volatile("s_waitcnt vmcnt(0)" ::: "memory"); __syncthreads();
    f32x16 ot[4], st0, st1, negm;
#pragma unroll
    for (int r = 0; r < 16; ++r) { negm[r] = 0.f; ot[0][r] = 0.f; ot[1][r] = 0.f; ot[2][r] = 0.f; ot[3][r] = 0.f; }
    float mref, lsum = 0.f;
    bf16x8 pb[4];
    AT_QK(0);
    { float mx; AT_ROWMAX(mx); mref = mx;
#pragma unroll
      for (int r = 0; r < 16; ++r) { st0[r] -= mx; st1[r] -= mx; negm[r] = -mx; }
      AT_EXPS(pb); }
    AT_QK(KS);
    __syncthreads();
    AT_DMA_K(2, 0); AT_DMA_V(1, VS0 + VS);
    asm volatile("s_waitcnt vmcnt(0)" ::: "memory"); __syncthreads();
    unsigned vs_prev = VS0, vs_cur = VS0 + VS, vs_next = VS0 + 2 * VS;
    for (int t = 1; t < 68; ++t) {
        const unsigned kcur = ((t + 1) & 1) * KS, kwr = (t & 1) * KS;
        if (t + 2 < 68) AT_DMA_K(t + 2, kwr);
        if (t + 1 < 68) AT_DMA_V(t + 1, vs_next);
        float mx; AT_ROWMAX(mx);
        AT_PV(vs_prev);
        if (__any(mx > 8.0f)) {
            const float dl = fmaxf(mx, 0.f), alpha = __builtin_amdgcn_exp2f(-dl);
            mref += dl; lsum *= alpha;
#pragma unroll
            for (int r = 0; r < 16; ++r) { st0[r] -= dl; st1[r] -= dl; negm[r] = -mref; ot[0][r] *= alpha; ot[1][r] *= alpha; ot[2][r] *= alpha; ot[3][r] *= alpha; }
        }
        AT_EXPS(pb);
        if (t + 1 < 68) AT_QK(kcur);
        asm volatile("s_waitcnt vmcnt(0)" ::: "memory"); __syncthreads();
        { const unsigned tmp_ = vs_prev; vs_prev = vs_cur; vs_cur = vs_next; vs_next = tmp_; }
    }
    AT_PV(vs_prev);
    __syncthreads();
#undef AT_DMA_K
#undef AT_DMA_V
#undef AT_QK
#undef AT_PV
#undef AT_ROWMAX
#undef AT_EXPS
    const float l = xhalf_sum(lsum);
    const float inv = 1.0f / l;
    LAS float* cbuf = (LAS float*)lds;
    if (map == 1) {
        const float sc = inv * lam;
#pragma unroll
        for (int d = 0; d < 4; ++d)
#pragma unroll
            for (int r = 0; r < 16; ++r) cbuf[(wq * 128 + 32 * d + crow(r, hi)) * 32 + r32] = ot[d][r] * sc;
    }
    __syncthreads();
    if (map == 0) {
        float ss = 0.f;
#pragma unroll
        for (int d = 0; d < 4; ++d)
#pragma unroll
            for (int r = 0; r < 16; ++r) { const float o = ot[d][r] * inv - cbuf[(wq * 128 + 32 * d + crow(r, hi)) * 32 + r32]; ot[d][r] = o; ss += o * o; }
        ss = xhalf_sum(ss);
        const float rs = rsqrtf(ss * (1.0f / 128.0f) + EPSN) * 0.8f;
        bf16_t* dst = (bf16_t*)(P.ws + WS_D) + (size_t)(b * 4096 + qb * 128 + wq * 32 + r32) * 1024 + 512 + h * 128;
#pragma unroll
        for (int d = 0; d < 4; ++d)
#pragma unroll
            for (int g = 0; g < 4; ++g) {
                const int d0 = 32 * d + 8 * g + 4 * hi;
                const f32x4 gg = *(const f32x4*)(P.subln_g + d0);
                u32x2v w; w.x = pk2(ot[d][4 * g] * rs * gg[0], ot[d][4 * g + 1] * rs * gg[1]); w.y = pk2(ot[d][4 * g + 2] * rs * gg[2], ot[d][4 * g + 3] * rs * gg[3]);
                *(u32x2v*)(dst + d0) = w;
            }
    }
}

constexpr int UPITCH = 5000, UPAD = 448;
constexpr unsigned HY_RE = 8 * UPITCH * 2, HY_RO = HY_RE + 16384 + 64;
DI void hyena_load_filter(const bf16_t* Rg, LAS uchar* lds, int tid) {
    for (int v = tid; v < 1024; v += 512) {
        const u32x4v a = *(const u32x4v*)(Rg + 8 * v);
        *(LAS u32x4v*)(lds + HY_RE + 16 * v) = a;
        const unsigned nx = (v < 1023) ? (unsigned)Rg[8 * v + 8] : 0u;
        u32x4v o; o.x = (a.x >> 16) | (a.y << 16); o.y = (a.y >> 16) | (a.z << 16); o.z = (a.z >> 16) | (a.w << 16); o.w = (a.w >> 16) | (nx << 16);
        *(LAS u32x4v*)(lds + HY_RO + 16 * v) = o;
    }
}
DI void hyena_unit(const Params& P, LAS uchar* lds, int c, int slot) {
    int tid_ = threadIdx.x; asm volatile("" : "+v"(tid_));
    const int tid = tid_, lane = tid & 63, w = __builtin_amdgcn_readfirstlane(tid >> 6), r32 = lane & 31, hi = lane >> 5;
    LAS bf16_t* U = (LAS bf16_t*)lds;
    const bf16_t* UT = (const bf16_t*)(P.ws + WS_UT);
    const bf16_t* R = (const bf16_t*)(P.ws + WS_R);
    bf16_t* scr = (bf16_t*)(P.ws + WS_A) + ((size_t)blockIdx.x * 2 + slot) * 32768;
    __syncthreads();
#pragma unroll 1
    for (int i = tid; i < 904; i += 512) {
        const int bb = i / 113, o = i % 113;
        const u32x4v z4 = {0u, 0u, 0u, 0u};
        *(LAS u32x4v*)(lds + bb * (UPITCH * 2) + (o < 56 ? o * 16 : (UPAD + 4096) * 2 + (o - 56) * 16)) = z4;
    }
    {
        const float w0 = P.hy_conv_w[c], w1 = P.hy_conv_w[1536 + c], w2 = P.hy_conv_w[3072 + c], cb = P.hy_conv_b[c];
#pragma unroll
        for (int i = 0; i < 8; ++i) {
            const int ch = tid + 512 * i, bb = ch >> 9, t8 = (ch & 511) * 8;
            const bf16_t* src = UT + ((size_t)(bb * 1536 + c) << 12) + t8;
            const u32x4v raw = *(const u32x4v*)src;
            float f[10];
            f[0] = t8 > 0 ? bf2f(src[-1]) : 0.f; f[9] = t8 + 8 < 4096 ? bf2f(src[8]) : 0.f;
#pragma unroll
            for (int q = 0; q < 4; ++q) { f[1 + 2 * q] = bf2f(raw[q] & 0xffffu); f[2 + 2 * q] = bf2f(raw[q] >> 16); }
            float o[8];
#pragma unroll
            for (int e = 0; e < 8; ++e) o[e] = w0 * f[e] + w1 * f[e + 1] + w2 * f[e + 2] + cb;
            u32x4v pw; pw.x = pk2(o[0], o[1]); pw.y = pk2(o[2], o[3]); pw.z = pk2(o[4], o[5]); pw.w = pk2(o[6], o[7]);
            *(LAS u32x4v*)(lds + (bb * UPITCH + UPAD + t8) * 2) = pw;
        }
    }
    hyena_load_filter(R + ((size_t)c << 13), lds, tid);
    __syncthreads();
    const int Iloc = r32 >> 3, bb = r32 & 7;
    const int ubase = (bb * UPITCH + UPAD + 64 * Iloc + 8 * hi) * 2;
    for (int ord = 0; ord < 2; ++ord) {
        f32x16 acc[2][2];
#pragma unroll
        for (int a = 0; a < 2; ++a)
#pragma unroll
            for (int m = 0; m < 2; ++m)
#pragma unroll
                for (int r = 0; r < 16; ++r) acc[a][m][r] = 0.f;
#define HY_LA(D, AF) do { const int q00 = 4096 - 64 * (D) - r32 + 8 * hi; \
            const unsigned abase = (q00 & 1) ? HY_RO + (unsigned)((q00 - 1) >> 1) * 4u : HY_RE + (unsigned)(q00 >> 1) * 4u; \
            _Pragma("unroll") for (int i = 0; i < 6; ++i) { u32x4v t_; \
                _Pragma("unroll") for (int e = 0; e < 4; ++e) t_[e] = *(LAS const unsigned*)(lds + abase + (8 * (i - 2) + e) * 4); AF[i] = __builtin_bit_cast(bf16x8, t_); } } while (0)
#define HY_LB(D, NBL, BF) do { _Pragma("unroll") for (int s = 0; s < 4; ++s) BF[s] = *(LAS const bf16x8*)(lds + ubase + (8 * w + 4 * (NBL) - (D)) * 128 + s * 32); } while (0)
#define HY_M(AF, BF, NBL) do { _Pragma("unroll") for (int s = 0; s < 4; ++s) { acc[NBL][0] = MFMA32(AF[s + 2], BF[s], acc[NBL][0]); acc[NBL][1] = MFMA32(AF[s], BF[s], acc[NBL][1]); } } while (0)
        {
            const int d0 = 8 * w - 63, d1 = 8 * w + 7;
            bf16x8 afA[6], afB[6], bf0[4], bf1[4];
            HY_LA(d0, afA); HY_LB(d0, 0, bf0);
#pragma unroll 1
            for (int d = d0; d < d1; d += 2) {
                const int dn = d + 2 <= d1 ? d + 2 : d1;
                HY_LB(d, 1, bf1); HY_M(afA, bf0, 0); HY_LA(d + 1, afB); HY_LB(d + 1, 0, bf0); HY_M(afA, bf1, 1);
                HY_LB(d + 1, 1, bf1); HY_M(afB, bf0, 0); HY_LA(dn, afA); HY_LB(dn, 0, bf0); HY_M(afB, bf1, 1);
            }
            HY_LB(d1, 1, bf1); HY_M(afA, bf0, 0); HY_M(afA, bf1, 1);
        }
#undef HY_LA
#undef HY_LB
#undef HY_M
        const int xch = 512 * (ord + 1) + c;
        const float w0 = P.hy_conv_w[xch], w1 = P.hy_conv_w[1536 + xch], w2 = P.hy_conv_w[3072 + xch], cb = P.hy_conv_b[xch];
        const float dbias = P.hy_bias[ord * 512 + c];
        const bf16_t* xg = UT + ((size_t)(bb * 1536 + xch) << 12);
        unsigned zp[2][2][8];
#pragma unroll
        for (int nbl = 0; nbl < 2; ++nbl)
#pragma unroll
            for (int mb = 0; mb < 2; ++mb) {
                const int base = 64 * (8 * w + 4 * nbl + Iloc) + 32 * mb;
                u32x4v W[4];
#pragma unroll
                for (int g = 0; g < 4; ++g) W[g] = *(const u32x4v*)(xg + base + 8 * g);
                const int eidx = hi ? base + 32 : base - 1;
                const unsigned ebits = (eidx >= 0 && eidx < 4096) ? (unsigned)xg[eidx] : 0u;
#pragma unroll
                for (int g = 0; g < 4; ++g) {
                    const int t4 = base + 8 * g + 4 * hi;
                    const u32x2v uu = *(LAS const u32x2v*)(lds + (bb * UPITCH + UPAD + t4) * 2);
                    const unsigned pd3 = (g > 0) ? W[g > 0 ? g - 1 : 0][3] : (ebits << 16), nd0 = (g < 3) ? W[g < 3 ? g + 1 : 3][0] : ebits;
                    const unsigned dA = hi ? W[g][1] : pd3, dB = hi ? W[g][2] : W[g][0], dC = hi ? W[g][3] : W[g][1], dD = hi ? nd0 : W[g][2];
                    float f[6];
                    f[0] = bf2f(dA >> 16); f[1] = bf2f(dB & 0xffffu); f[2] = bf2f(dB >> 16); f[3] = bf2f(dC & 0xffffu); f[4] = bf2f(dC >> 16); f[5] = bf2f(dD & 0xffffu);
                    const float u0 = bf2f(uu.x & 0xffffu), u1 = bf2f(uu.x >> 16), u2 = bf2f(uu.y & 0xffffu), u3 = bf2f(uu.y >> 16);
                    const float z0 = (w0 * f[0] + w1 * f[1] + w2 * f[2] + cb) * (acc[nbl][mb][4 * g + 0] + dbias * u0);
                    const float z1 = (w0 * f[1] + w1 * f[2] + w2 * f[3] + cb) * (acc[nbl][mb][4 * g + 1] + dbias * u1);
                    const float z2 = (w0 * f[2] + w1 * f[3] + w2 * f[4] + cb) * (acc[nbl][mb][4 * g + 2] + dbias * u2);
                    const float z3 = (w0 * f[3] + w1 * f[4] + w2 * f[5] + cb) * (acc[nbl][mb][4 * g + 3] + dbias * u3);
                    asm volatile("" ::: "memory");
                    if (ord == 0) { zp[nbl][mb][2 * g] = pk2(z0, z1); zp[nbl][mb][2 * g + 1] = pk2(z2, z3); }
                    else {
                        u32x2v pz; pz.x = pk2(z0, z1); pz.y = pk2(z2, z3);
                        *(u32x2v*)(scr + bb * 4096 + t4) = pz;
                    }
                }
            }
        if (ord == 0) {
            __syncthreads();
#pragma unroll
            for (int nbl = 0; nbl < 2; ++nbl)
#pragma unroll
                for (int mb = 0; mb < 2; ++mb)
#pragma unroll
                    for (int g = 0; g < 4; ++g) {
                        const int t4 = 64 * (8 * w + 4 * nbl + Iloc) + 32 * mb + 8 * g + 4 * hi;
                        u32x2v zz; zz.x = zp[nbl][mb][2 * g]; zz.y = zp[nbl][mb][2 * g + 1];
                        *(LAS u32x2v*)(lds + (bb * UPITCH + UPAD + t4) * 2) = zz;
                    }
            hyena_load_filter(R + ((size_t)(512 + c) << 13), lds, tid);
            __syncthreads();
        }
    }
}

DI void hyena_flush(const Params& P, int c0) {
    asm volatile("s_waitcnt vmcnt(0)" ::: "memory");
    __syncthreads();
    const unsigned long long* sa = (const unsigned long long*)((const bf16_t*)(P.ws + WS_A) + (size_t)blockIdx.x * 2 * 32768);
    const unsigned long long* sb = sa + 8192;
    bf16_t* Z = (bf16_t*)(P.ws + WS_D);
#pragma unroll 4
    for (int i = threadIdx.x; i < 8192; i += 512) {
        const unsigned long long a = __hip_atomic_load(sa + i, __ATOMIC_RELAXED, __HIP_MEMORY_SCOPE_AGENT), b = __hip_atomic_load(sb + i, __ATOMIC_RELAXED, __HIP_MEMORY_SCOPE_AGENT);
        const unsigned a0 = (unsigned)a, a1 = (unsigned)(a >> 32), b0 = (unsigned)b, b1 = (unsigned)(b >> 32);
        unsigned* zm = (unsigned*)(Z + (size_t)(4 * i) * 1024 + c0);
        zm[0] = (a0 & 0xffffu) | (b0 << 16); zm[512] = (a0 >> 16) | (b0 & 0xffff0000u); zm[1024] = (a1 & 0xffffu) | (b1 << 16); zm[1536] = (a1 >> 16) | (b1 & 0xffff0000u);
    }
    __syncthreads();
}

#define XB_TMO      128
#define XB_XCNT(j)  (256  + 64 * (j))
#define XB_XSUB(j)  (1280 + 64 * (j))
#define XB_XGEN(j)  (2304 + 64 * (j))
#define XB_TOP      3328
#define XB_TOPGEN   3392
#define XCD_BAR_WORDS 3456
#define XB_SPIN_CAP (1u << 18)

__device__ __forceinline__ unsigned xb_ld(unsigned* p)              { return __hip_atomic_load(p, __ATOMIC_RELAXED, __HIP_MEMORY_SCOPE_AGENT); }
__device__ __forceinline__ unsigned xb_add(unsigned* p, unsigned v) { return __hip_atomic_fetch_add(p, v, __ATOMIC_RELAXED, __HIP_MEMORY_SCOPE_AGENT); }
__device__ __forceinline__ unsigned xb_xcc_id() { return (unsigned)__builtin_amdgcn_s_getreg((3 << 11) | 20) & 0xFu; }
#define XB_SPIN(cond, bar) do { unsigned _sp = 0; while (cond) { __builtin_amdgcn_s_sleep(1); \
    if ((++_sp & 255u) == 0u) { if (xb_ld(&(bar)[XB_TMO])) break; if (_sp > XB_SPIN_CAP) { atomicAdd(&(bar)[XB_TMO], 1u); break; } } } } while (0)

struct XcdBarrier {
    unsigned* bar; unsigned x;
    volatile LAS unsigned* st;
};

__device__ __forceinline__ XcdBarrier xcd_barrier_post(unsigned* bar, volatile LAS unsigned* st) {
    XcdBarrier b; b.bar = bar; b.x = xb_xcc_id(); b.st = st;
    if (threadIdx.x == 0) (void)xb_add(&bar[XB_XCNT(b.x)], 1u);
    return b;
}
__device__ __forceinline__ void xcd_barrier_complete(unsigned* bar, unsigned x, unsigned& nloc, unsigned& nx) {
    const unsigned G = gridDim.x * gridDim.y * gridDim.z;
    unsigned sum, cnt, mine, sp = 0u;
    for (;;) {
        sum = 0u; cnt = 0u; mine = 0u;
#pragma unroll
        for (unsigned j = 0; j < 16; ++j) { const unsigned c = xb_ld(&bar[XB_XCNT(j)]); sum += c; cnt += (c > 0u) ? 1u : 0u; mine = (j == x) ? c : mine; }
        if (sum == G) break;
        __builtin_amdgcn_s_sleep(1);
        if ((++sp & 255u) == 0u) { if (xb_ld(&bar[XB_TMO])) break; if (sp > XB_SPIN_CAP) { atomicAdd(&bar[XB_TMO], 1u); break; } }
    }
    nloc = mine > 0u ? mine : 1u; nx = cnt > 0u ? cnt : 1u;
}

__device__ __forceinline__ void xcd_barrier(const XcdBarrier& b) {
    asm volatile("s_waitcnt vmcnt(0)" ::: "memory");
    __syncthreads();
    if (threadIdx.x == 0) {
        unsigned* bar = b.bar;
        __builtin_amdgcn_s_waitcnt(0);
        unsigned nloc = b.st[0], nx = b.st[1];
        if (nloc == 0u) { xcd_barrier_complete(bar, b.x, nloc, nx); b.st[0] = nloc; b.st[1] = nx; }
        const unsigned old = xb_add(&bar[XB_XSUB(b.x)], 1u);
        const unsigned gen = old / nloc;
        if (old + 1u == (gen + 1u) * nloc) {
            __builtin_amdgcn_fence(__ATOMIC_RELEASE, "agent");
            asm volatile("s_waitcnt vmcnt(0)" ::: "memory");
            const unsigned og = xb_add(&bar[XB_TOP], 1u);
            const unsigned tg = og / nx;
            if (og + 1u == (tg + 1u) * nx) xb_add(&bar[XB_TOPGEN], 1u);
            else XB_SPIN(xb_ld(&bar[XB_TOPGEN]) == tg, bar);
            __builtin_amdgcn_fence(__ATOMIC_ACQUIRE, "agent");
            xb_add(&bar[XB_XGEN(b.x)], 1u);
            asm volatile("s_waitcnt vmcnt(0)" ::: "memory");
        } else {
            XB_SPIN(xb_ld(&bar[XB_XGEN(b.x)]) == gen, bar);
            __builtin_amdgcn_fence(__ATOMIC_ACQUIRE, "agent");
            asm volatile("s_waitcnt vmcnt(0)" ::: "memory");
        }
    }
    __syncthreads();
}


__global__ void __launch_bounds__(512, 2) mega(Params P) {
    extern __shared__ __attribute__((aligned(16))) unsigned char smem[];
    LAS uchar* lds = (LAS uchar*)smem;
    uchar* ws = P.ws;
    const int G = gridDim.x, bid = blockIdx.x;
    volatile LAS unsigned* xst = (volatile LAS unsigned*)(lds + 131072);
    if (threadIdx.x == 0) { xst[0] = 0u; xst[1] = 0u; }
    __syncthreads();
    const XcdBarrier xb = xcd_barrier_post((unsigned*)(ws + WS_BAR), xst);
#define RUN(k) if (P.ph_lo <= (k) && (k) < P.ph_hi)
#define SEAM(k) if (P.ph_lo <= (k) && (k) + 1 < P.ph_hi) xcd_barrier(xb);
    RUN(0) phase_prep(P, lds);
    SEAM(0)
    RUN(1) phase_norm1(P);
    SEAM(1)
    RUN(2) {
        for (int rep = 0; rep < PROBE_P2; ++rep)
        { pg8::StaticOrder S; S.init(NTOK, NCOLS, G, bid);
          pg8::Gemm g{(const bf16_t*)(ws + WS_A), (const bf16_t*)(ws + WS_WIN), NTOK, NCOLS, 1024};
          EpiIn E{(bf16_t*)(ws + WS_UT), (bf16_t*)(ws + WS_Q), (bf16_t*)(ws + WS_K), (bf16_t*)(ws + WS_V), (bf16_t*)(ws + WS_C), (const float*)(ws + WS_ROPE)};
          pg8::gemm_phase<EpiIn, pg8::StaticOrder, true, true>(lds, g, S, E); }
        { pg8::StaticOrder S; S.init(NCTX, 1024, G, bid);
          pg8::Gemm g{(const bf16_t*)(ws + WS_HC), (const bf16_t*)(ws + WS_WIN) + (size_t)2048 * 1024, NCTX, 1024, 1024};
          EpiCtx E{(bf16_t*)(ws + WS_K), (bf16_t*)(ws + WS_V)};
          pg8::gemm_phase<EpiCtx, pg8::StaticOrder, true, true>(lds, g, S, E); }
        if (G > 32) { if (bid >= 32) tconv_range(P, threadIdx.x, NCOPY_EARLY, NCOPY_ALL, bid - 32, G - 32); }
        else tconv_range(P, threadIdx.x, NCOPY_EARLY, NCOPY_ALL, bid, G);
    }
    SEAM(2)
    RUN(3) {
        const int xcd = bid & 7, idx = bid >> 3;
        if (G == 256) {
            for (int rep = 0; rep < PROBE_HY; ++rep)
            for (int j = 0; j < 2; ++j) hyena_unit(P, lds, xcd * 64 + idx * 2 + j, j);
            hyena_flush(P, xcd * 64 + idx * 2);
        } else { for (int c2 = bid; c2 < 256; c2 += G) { for (int j = 0; j < 2; ++j) hyena_unit(P, lds, 2 * c2 + j, j); hyena_flush(P, 2 * c2); } }
        const float lam = ((const float*)(ws + WS_MISC))[0];
        if (G == 256) {
            for (int rep = 0; rep < PROBE_AT; ++rep)
            for (int j = 0; j < 4; ++j) { const int bh = j * 8 + xcd; attn_unit(P, lds, bh >> 2, bh & 3, idx, lam); }
        } else { for (int u = bid; u < 1024; u += G) attn_unit(P, lds, u >> 7, (u >> 5) & 3, u & 31, lam); }
        __syncthreads();
    }
    SEAM(3)
    RUN(4) {
        HalfOrder S; S.base.init(NTOK, 1024, G, bid); S.khalf_bytes = 512 * 2;
        pg8::Gemm g{(const bf16_t*)(ws + WS_D), (const bf16_t*)(ws + WS_WHY), NTOK, 1024, 512, 1024};
        EpiUpM E{(const bf16_t*)(ws + WS_C), (bf16_t*)(ws + WS_A)};
        pg8::gemm_phase<EpiUpM, HalfOrder, true, true>(lds, g, S, E);
    }
    SEAM(4)
    RUN(5) {
        pg8::StaticOrder S; S.init(NTOK, 1024, G, bid);
        pg8::Gemm g{(const bf16_t*)(ws + WS_A), (const bf16_t*)(ws + WS_WOUT), NTOK, 1024, 1024};
        EpiSsq E{(bf16_t*)(ws + WS_C), (float*)(ws + WS_SSQ)};
        pg8::gemm_phase<EpiSsq, pg8::StaticOrder, true, true>(lds, g, S, E);
    }
    SEAM(5)
    RUN(6) phase_mid(P);
    SEAM(6)
    RUN(7) for (int rep = 0; rep < PROBE_P7; ++rep) {
        pg8::StaticOrder S; S.init(NTOK, NGU, G, bid);
        pg8::Gemm g{(const bf16_t*)(ws + WS_A), (const bf16_t*)(ws + WS_WGU), NTOK, NGU, 1024};
        EpiGU E{(bf16_t*)(ws + WS_B)};
        pg8::gemm_phase<EpiGU, pg8::StaticOrder, true, true>(lds, g, S, E);
    }
    SEAM(7)
    RUN(8) {
        pg8::StaticOrder S; S.init(NTOK, 1024, G, bid);
        pg8::Gemm g{(const bf16_t*)(ws + WS_B), (const bf16_t*)(ws + WS_WDN), NTOK, 1024, DFF};
        EpiSsq E{(bf16_t*)(ws + WS_C + (size_t)NTOK * 1024 * 2), (float*)(ws + WS_SSQ) + NTOK};
        pg8::gemm_phase<EpiSsq, pg8::StaticOrder, true, true>(lds, g, S, E);
    }
    SEAM(8)
    RUN(9) phase_final(P);
}

extern "C" void kernel_launch(void* const* d_in, const int* in_sizes, int n_in, void* d_out, int out_size, void* d_ws, size_t ws_size, hipStream_t stream) {
    static int grid = 0;
    if (grid == 0) {
        if (n_in != 32 || ws_size < WS_END) { fprintf(stderr, "kernel_launch: unexpected n_in %d / ws_size %zu (need %zu)\n", n_in, ws_size, (size_t)WS_END); grid = -1; return; }
        int dev = 0, cus = 0, per_cu = 0;
        hipGetDevice(&dev);
        hipDeviceGetAttribute(&cus, hipDeviceAttributeMultiprocessorCount, dev);
        if (hipFuncSetAttribute((const void*)mega, hipFuncAttributeMaxDynamicSharedMemorySize, LDS_BYTES) != hipSuccess) { fprintf(stderr, "kernel_launch: hipFuncSetAttribute failed\n"); grid = -1; return; }
        if (hipOccupancyMaxActiveBlocksPerMultiprocessor(&per_cu, (const void*)mega, 512, LDS_BYTES) != hipSuccess || per_cu < 1) { fprintf(stderr, "kernel_launch: occupancy query says %d\n", per_cu); per_cu = 1; }
        (void)hipGetLastError();
        grid = cus * 1;
        fprintf(stderr, "kernel_launch: cus %d per_cu %d grid %d\n", cus, per_cu, grid);
    }
    if (grid < 0) return;
    if (hipMemsetAsync((char*)d_ws + WS_BAR, 0, 14336, stream) != hipSuccess) { fprintf(stderr, "kernel_launch: memset failed\n"); return; }
    Params p{};
    const float** pp = (const float**)&p;
    for (int i = 0; i < 32; ++i) pp[i] = (const float*)d_in[i];
    p.out = (float*)d_out; p.ws = (unsigned char*)d_ws;
#if N_LAUNCH == 1
    p.ph_lo = 0; p.ph_hi = NPH;
    hipLaunchKernelGGL(mega, dim3(grid), dim3(512), LDS_BYTES, stream, p);
#else
    for (int k = 0; k < NPH; ++k) { p.ph_lo = k; p.ph_hi = k + 1; hipLaunchKernelGGL(mega, dim3(grid), dim3(512), LDS_BYTES, stream, p); }
#endif
}
```

```cpp
#include <hip/hip_runtime.h>
#include <hip/hip_cooperative_groups.h>
#include <cstdio>
#include <cstdint>
namespace cg = cooperative_groups;
#define N_LAUNCH 1
namespace pg8 {
#define PG8_LAS __attribute__((address_space(3)))
typedef unsigned short bf16_t;
typedef short bf16x8 __attribute__((ext_vector_type(8)));
typedef float f32x4 __attribute__((ext_vector_type(4)));
typedef unsigned u32x4 __attribute__((ext_vector_type(4)));
constexpr int BM = 256, BK = 64, HALF = 128, HTB = HALF * BK * 2  , STAGE_BYTES = 8 * HTB, NXCD = 8, WGM = 8;

__host__ __device__ __forceinline__ int lds_byte(int r, int c) { const int st = (r >> 4) * 2 + (c >> 5), rr = r & 15, cc = c & 31, ob = rr * 64 + cc * 2; return st * 1024 + (ob ^ (((ob >> 9) & 1) << 5)); }
__host__ __device__ __forceinline__ void stage_rc(int b, int& R, int& C) { const int st = b / 1024, sb = b % 1024, swz = sb ^ (((sb >> 9) & 1) << 5); R = (st >> 1) * 16 + swz / 64; C = (st & 1) * 32 + (swz % 64) / 2; }
__host__ __device__ __forceinline__ int perm32(int rho) { const int n = rho >> 4, i = rho & 15; return 8 * (i >> 2) + 4 * n + (i & 3); }

struct Unit { int pm, pn; int koff = 0, half = 0; };
struct Gemm { const bf16_t* A; const bf16_t* Bt; int M, N, K; int ld = 0; };

struct StaticOrder {
    int nM, nN, nwg, G, c;
    __host__ __device__ void init(int M, int N, int G_, int c_) { nM = M / BM; nN = N / BM; nwg = nM * nN; G = G_; c = c_; }
    __host__ __device__ bool next(int i, Unit& u) const {
        const long L = (long)i * G + c; if (L >= nwg) return false;
        int wgid = (int)L; { const int q = nwg / NXCD, r = nwg % NXCD, xcd = wgid % NXCD, off = wgid / NXCD; wgid = (xcd < r ? xcd * (q + 1) : r * (q + 1) + (xcd - r) * q) + off; }
        const int nig = WGM * nN, gid = wgid / nig, fm = gid * WGM, gsz = (nM - fm) < WGM ? (nM - fm) : WGM;
        u.pm = fm + ((wgid % nig) % gsz); u.pn = (wgid % nig) / gsz; return true;
    }
    __device__ __forceinline__ void a_ready(const Unit&) const {}
    __device__ __forceinline__ void done(const Unit&) const {}
};
__device__ __forceinline__ unsigned cvt_pk_bf16(float lo, float hi) { unsigned r; asm volatile("v_cvt_pk_bf16_f32 %0, %1, %2" : "=v"(r) : "v"(lo), "v"(hi)); return r; }
template <class Epi, class Sched, bool ALIGN_EPI = false, bool SP2 = false>
__device__ __forceinline__ void gemm_phase(PG8_LAS unsigned char* lds, const Gemm g, const Sched& S, const Epi& E) {
    const int tid = threadIdx.x, wid = __builtin_amdgcn_readfirstlane(tid >> 6), lane = tid & 63, wr = wid >> 2, wc = wid & 3, fr = lane & 15, fq = lane >> 4;
    const int K = g.ld ? g.ld : g.K, nt = g.K / BK;
    unsigned voffA[2], voffB[2];
#pragma unroll
    for (int i = 0; i < 2; ++i) { int R, C; stage_rc(tid * 16 + i * 8192, R, C); const int Rb = Epi::PERM ? ((R & ~31) + perm32(R & 31)) : R;
        voffA[i] = (unsigned)(R * K + C) * 2u; voffB[i] = (unsigned)(Rb * K + C) * 2u; }
    const size_t kstep = (size_t)(BK * 2);
    const size_t hstep = (size_t)HALF * K * 2;
    const size_t tstep = 2 * hstep;
    const unsigned ldsw = (unsigned)wid * 1024u;
    const int aoff = lds_byte(wr * 64 + fr, fq * 8), boff = lds_byte(wc * 32 + fr, fq * 8);
#define PG8_SA(b, h) (((b) * 2 + (h)) * HTB)
#define PG8_SB(b, h) ((4 + (b) * 2 + (h)) * HTB)
#define PG8_STAGE(bufoff, gbase, voff) do { _Pragma("unroll") for (int _i = 0; _i < 2; ++_i) \
        __builtin_amdgcn_global_load_lds((const unsigned*)((const char*)(gbase) + (voff)[_i]), (PG8_LAS unsigned*)(lds + (bufoff) + ldsw + _i * 8192), 16, 0, 0); } while (0)
#define PG8_LDA(dst, b, h) do { _Pragma("unroll") for (int m = 0; m < 4; ++m) _Pragma("unroll") for (int k = 0; k < 2; ++k) dst[m][k] = *(const PG8_LAS bf16x8*)(lds + PG8_SA(b, h) + aoff + m * 2048 + k * 1024); } while (0)
#define PG8_LDB(dst, b, h) do { _Pragma("unroll") for (int n = 0; n < 2; ++n) _Pragma("unroll") for (int k = 0; k < 2; ++k) dst[n][k] = *(const PG8_LAS bf16x8*)(lds + PG8_SB(b, h) + boff + n * 2048 + k * 1024); } while (0)
#define PG8_MMA(ai, bj, At, Bt) do { __builtin_amdgcn_s_setprio(1); _Pragma("unroll") for (int m = 0; m < 4; ++m) _Pragma("unroll") for (int n = 0; n < 2; ++n) _Pragma("unroll") for (int k = 0; k < 2; ++k) \
        acc[ai][bj][m][n] = __builtin_amdgcn_mfma_f32_16x16x32_bf16(Bt[n][k], At[m][k], acc[ai][bj][m][n], 0, 0, 0); __builtin_amdgcn_s_setprio(0); } while (0)
#define PG8_WAIT_V(n) asm volatile("s_waitcnt vmcnt(" #n ")" ::: "memory")
#define PG8_WAIT_L(n) asm volatile("s_waitcnt lgkmcnt(" #n ")" ::: "memory")
#define PG8_BAR __builtin_amdgcn_s_barrier()
#define PG8_SCHED __builtin_amdgcn_sched_barrier(0)
    Unit cur, nxt; int ui = 0;
    if (!S.next(0, cur)) return;
    f32x4 acc[2][2][4][2];
#pragma unroll
    for (int a = 0; a < 2; ++a)
#pragma unroll
        for (int b = 0; b < 2; ++b)
#pragma unroll
            for (int m = 0; m < 4; ++m)
#pragma unroll
                for (int n = 0; n < 2; ++n) acc[a][b][m][n] = (f32x4){0.f, 0.f, 0.f, 0.f};
    bf16x8 At[4][2], B0[2][2], B1[2][2];
    const char* cA = (const char*)g.A + (size_t)cur.pm * tstep + cur.koff; const char* cB = (const char*)g.Bt + (size_t)cur.pn * tstep + cur.koff;
    S.a_ready(cur);
    if constexpr (SP2) {
        PG8_STAGE(PG8_SB(0, 0), cB, voffB); PG8_STAGE(PG8_SB(0, 1), cB + hstep, voffB); PG8_STAGE(PG8_SA(0, 0), cA, voffA); PG8_STAGE(PG8_SA(0, 1), cA + hstep, voffA);
        if (wr == 1) PG8_BAR;
        PG8_WAIT_V(2); PG8_BAR;
        PG8_STAGE(PG8_SB(1, 0), cB + kstep, voffB); PG8_STAGE(PG8_SA(1, 0), cA + kstep, voffA); PG8_STAGE(PG8_SB(1, 1), cB + hstep + kstep, voffB);
        PG8_WAIT_V(6); PG8_BAR;
    } else {
        PG8_STAGE(PG8_SB(0, 0), cB, voffB); PG8_STAGE(PG8_SA(0, 0), cA, voffA); PG8_STAGE(PG8_SB(0, 1), cB + hstep, voffB); PG8_STAGE(PG8_SA(0, 1), cA + hstep, voffA);
        if (wr == 1) PG8_BAR;
        PG8_WAIT_V(4); PG8_BAR;
        PG8_STAGE(PG8_SB(1, 0), cB + kstep, voffB); PG8_STAGE(PG8_SA(1, 0), cA + kstep, voffA); PG8_STAGE(PG8_SB(1, 1), cB + hstep + kstep, voffB);
        PG8_WAIT_V(6); PG8_BAR;
    }
    for (;;) {
        const bool has_next = S.next(ui + 1, nxt);
        const char* nA = has_next ? (const char*)g.A + (size_t)nxt.pm * tstep + nxt.koff : cA; const char* nB = has_next ? (const char*)g.Bt + (size_t)nxt.pn * tstep + nxt.koff : cB;
        for (int t = 0; t < nt; t += 2) {
            const bool last = (t == nt - 2);
            const char* a1 = cA + (size_t)(t + 1) * kstep;
            const char* a2 = last ? nA : cA + (size_t)(t + 2) * kstep; const char* b2 = last ? nB : cB + (size_t)(t + 2) * kstep;
            const char* a3 = a2 + kstep; const char* b3 = b2 + kstep;
            if (last && has_next) S.a_ready(nxt);
            if constexpr (SP2) {
            PG8_LDB(B0, 0, 0); PG8_LDB(B1, 0, 1); PG8_SCHED; PG8_LDA(At, 0, 0); PG8_STAGE(PG8_SA(1, 1), a1 + hstep, voffA);
            PG8_WAIT_V(8); PG8_WAIT_L(0); PG8_BAR; PG8_MMA(0, 0, At, B0); PG8_MMA(0, 1, At, B1); PG8_BAR; PG8_SCHED;
            PG8_LDA(At, 0, 1); PG8_STAGE(PG8_SB(0, 0), b2, voffB); PG8_STAGE(PG8_SB(0, 1), b2 + hstep, voffB); PG8_STAGE(PG8_SA(0, 0), a2, voffA);
            PG8_WAIT_V(8); PG8_WAIT_L(0); PG8_BAR; PG8_MMA(1, 0, At, B0); PG8_MMA(1, 1, At, B1); PG8_BAR; PG8_SCHED;
            PG8_LDB(B0, 1, 0); PG8_LDB(B1, 1, 1); PG8_SCHED; PG8_LDA(At, 1, 0); PG8_STAGE(PG8_SA(0, 1), a2 + hstep, voffA);
            PG8_WAIT_V(8); PG8_WAIT_L(0); PG8_BAR; PG8_MMA(0, 0, At, B0); PG8_MMA(0, 1, At, B1); PG8_BAR; PG8_SCHED;
            PG8_LDA(At, 1, 1); PG8_STAGE(PG8_SB(1, 0), b3, voffB); PG8_STAGE(PG8_SB(1, 1), b3 + hstep, voffB); PG8_STAGE(PG8_SA(1, 0), a3, voffA);
            PG8_WAIT_V(8); PG8_WAIT_L(0); PG8_BAR; PG8_MMA(1, 0, At, B0); PG8_MMA(1, 1, At, B1); PG8_BAR; PG8_SCHED;
            } else {
            PG8_LDB(B0, 0, 0); PG8_SCHED; PG8_LDA(At, 0, 0); PG8_STAGE(PG8_SA(1, 1), a1 + hstep, voffA);
            PG8_WAIT_L(8); PG8_BAR; PG8_WAIT_L(0); PG8_MMA(0, 0, At, B0); PG8_BAR; PG8_SCHED;
            PG8_LDB(B1, 0, 1); PG8_STAGE(PG8_SB(0, 0), b2, voffB);
            PG8_BAR; PG8_WAIT_L(0); PG8_MMA(0, 1, At, B1); PG8_BAR;
            PG8_LDA(At, 0, 1); PG8_STAGE(PG8_SA(0, 0), a2, voffA);
            PG8_BAR; PG8_WAIT_L(0); PG8_MMA(1, 0, At, B0); PG8_BAR; PG8_SCHED;
            PG8_STAGE(PG8_SB(0, 1), b2 + hstep, voffB);
            PG8_WAIT_V(6); PG8_BAR; PG8_MMA(1, 1, At, B1); PG8_BAR;
            PG8_LDB(B0, 1, 0); PG8_SCHED; PG8_LDA(At, 1, 0); PG8_STAGE(PG8_SA(0, 1), a2 + hstep, voffA);
            PG8_WAIT_L(8); PG8_BAR; PG8_WAIT_L(0); PG8_MMA(0, 0, At, B0); PG8_BAR; PG8_SCHED;
            PG8_LDB(B1, 1, 1); PG8_STAGE(PG8_SB(1, 0), b3, voffB);
            PG8_BAR; PG8_WAIT_L(0); PG8_MMA(0, 1, At, B1); PG8_BAR;
            PG8_LDA(At, 1, 1); PG8_STAGE(PG8_SA(1, 0), a3, voffA);
            PG8_BAR; PG8_WAIT_L(0); PG8_MMA(1, 0, At, B0); PG8_BAR; PG8_SCHED;
            PG8_STAGE(PG8_SB(1, 1), b3 + hstep, voffB);
            PG8_WAIT_V(6); PG8_BAR; PG8_MMA(1, 1, At, B1); PG8_BAR;
            }
        }
        if constexpr (ALIGN_EPI) { if (wr == 0) PG8_BAR; }
        if constexpr (!Epi::AFTER_DRAIN) { E(acc, cur, wr, wc, fr, fq); S.done(cur); }
        if (!has_next) break;
        if (E.zero_after(cur))
#pragma unroll
        for (int a = 0; a < 2; ++a)
#pragma unroll
            for (int b = 0; b < 2; ++b)
#pragma unroll
                for (int m = 0; m < 4; ++m)
#pragma unroll
                    for (int n = 0; n < 2; ++n) acc[a][b][m][n] = (f32x4){0.f, 0.f, 0.f, 0.f};
        cur = nxt; cA = nA; cB = nB; ++ui;
        if constexpr (ALIGN_EPI) { if (wr == 1) PG8_BAR; }
    }
    PG8_WAIT_V(0);
    if constexpr (!ALIGN_EPI) { if (wr == 0) PG8_BAR; }
    PG8_BAR;
    if constexpr (Epi::AFTER_DRAIN) { E.fused(acc, cur, wr, wc, fr, fq, lds, wid, lane); S.done(cur); }
#undef PG8_SA
#undef PG8_SB
#undef PG8_STAGE
#undef PG8_LDA
#undef PG8_LDB
#undef PG8_MMA
#undef PG8_WAIT_V
#undef PG8_WAIT_L
#undef PG8_BAR
#undef PG8_SCHED
}
}

#ifndef N_LAUNCH
#define N_LAUNCH 1
#endif
#ifndef AT_SGB
#define AT_SGB 1
#endif
#ifndef AT_VARIANT
#define AT_VARIANT 1
#endif
#ifndef PROBE_HY
#define PROBE_HY 1
#endif
#ifndef PROBE_AT
#define PROBE_AT 1
#endif
#ifndef PROBE_P2
#define PROBE_P2 1
#endif
#ifndef PROBE_P7
#define PROBE_P7 1
#endif
#define LAS __attribute__((address_space(3)))
#define DI __device__ __forceinline__
typedef unsigned char uchar;
using pg8::bf16_t; using pg8::bf16x8; using pg8::f32x4;
typedef float f32x16 __attribute__((ext_vector_type(16)));
typedef short s16x4 __attribute__((ext_vector_type(4)));
typedef float f32x2_t __attribute__((ext_vector_type(2)));
typedef __bf16 bf16x2_t __attribute__((ext_vector_type(2)));

constexpr int DM = 1024, NB = 8, SEQ = 4096, NTOK = NB * SEQ, CTXL = 256, NCTX = NB * CTXL, LKV = SEQ + CTXL;
constexpr int DHY = 512, NCOLS = 5120, DFF = 2816, NGU = 2 * DFF;
constexpr float EPSN = 1e-6f;
constexpr int LDS_BYTES = 131072 + 64;
constexpr int NPH = 10;

constexpr size_t al256(size_t x) { return (x + 255) & ~(size_t)255; }
constexpr size_t WS_WIN = 0;
constexpr size_t WS_WHY = WS_WIN + (size_t)NCOLS * DM * 2;
constexpr size_t WS_WATT = WS_WHY + (size_t)DM * DHY * 2;
constexpr size_t WS_WOUT = WS_WATT + (size_t)DM * DHY * 2;
constexpr size_t WS_WGU = WS_WOUT + (size_t)DM * DM * 2;
constexpr size_t WS_WDN = WS_WGU + (size_t)NGU * DM * 2;
constexpr size_t WS_R = WS_WDN + (size_t)DM * DFF * 2;
constexpr size_t WS_ADA = WS_R + (size_t)2 * DHY * 8192 * 2;
constexpr size_t WS_ROPE = al256(WS_ADA + (size_t)9 * 6144 * 4);
constexpr size_t WS_MISC = WS_ROPE + 64 * 32 * 4;
constexpr size_t WS_BAR = WS_MISC + 256;
constexpr size_t WS_SSQ = WS_BAR + 14336;
constexpr size_t WS_HC = WS_SSQ + (size_t)2 * NTOK * 4;
constexpr size_t WS_A = WS_HC + (size_t)NCTX * DM * 2;
constexpr size_t WS_B = WS_A + (size_t)NTOK * DM * 2;
constexpr size_t WS_UT = WS_B;
constexpr size_t WS_Q = WS_UT + (size_t)NB * 1536 * SEQ * 2;
constexpr size_t WS_K = WS_Q + (size_t)NTOK * 512 * 2;
constexpr size_t WS_V = WS_K + (size_t)NB * LKV * 512 * 2;
constexpr size_t WS_BEND = WS_V + (size_t)NB * LKV * 512 * 2;
constexpr size_t WS_C = WS_BEND;
constexpr size_t WS_D = WS_C + (size_t)NTOK * 2048 * 2;
constexpr size_t WS_END = WS_D + (size_t)2 * NTOK * 512 * 2;
static_assert((size_t)NTOK * DFF * 2 <= WS_BEND - WS_B, "ACT must fit region B");
static_assert(WS_END <= (size_t)536870912, "workspace map exceeds 512 MiB");

struct Params {
    const float *x, *c, *ctx, *c_ctx, *w_ada, *b_ada, *g_mix_pre, *g_mix_post, *g_ffn_pre, *g_ffn_post,
        *w_in, *hy_conv_w, *hy_conv_b, *f_w1, *f_b1, *f_w2, *f_b2, *f_w3, *f_b3, *f_freq, *hy_bias,
        *lq1, *lk1, *lq2, *lk2, *subln_g, *w_hy_up, *w_att_up, *w_out, *w_gate, *w_up, *w_down;
    float* out; unsigned char* ws; int ph_lo, ph_hi;
};

DI float bf2f(unsigned v) { return __uint_as_float(v << 16); }
DI unsigned pk2(float lo, float hi) { f32x2_t v = {lo, hi}; bf16x2_t b = __builtin_convertvector(v, bf16x2_t); return __builtin_bit_cast(unsigned, b); }
DI bf16_t f2bf(float x) { return (bf16_t)(pk2(x, 0.f) & 0xffffu); }
DI int crow(int r, int hi) { return (r & 3) + 8 * (r >> 2) + 4 * hi; }
DI float wave_sum(float v) {
#pragma unroll
    for (int o = 32; o > 0; o >>= 1) v += __shfl_xor(v, o);
    return v;
}
#define MFMA32(a, b, c) __builtin_amdgcn_mfma_f32_32x32x16_bf16((a), (b), (c), 0, 0, 0)
typedef short v4i16_t __attribute__((ext_vector_type(4)));
DI s16x4 vtr(LAS const uchar* p) { return __builtin_bit_cast(s16x4, __builtin_amdgcn_ds_read_tr16_b64_v4i16((LAS v4i16_t*)p)); }
DI bf16x8 pack8(const f32x16& x, int s) {
    typedef unsigned u32x4_t __attribute__((ext_vector_type(4)));
    u32x4_t p;
    if (s == 0) { p[0] = pk2(x[0], x[1]); p[1] = pk2(x[2], x[3]); p[2] = pk2(x[4], x[5]); p[3] = pk2(x[6], x[7]); }
    else        { p[0] = pk2(x[8], x[9]); p[1] = pk2(x[10], x[11]); p[2] = pk2(x[12], x[13]); p[3] = pk2(x[14], x[15]); }
    return __builtin_bit_cast(bf16x8, p);
}

#define EPI_ARGS const f32x4 (&acc)[2][2][4][2], const pg8::Unit& u, int wr, int wc, int fr, int fq
typedef unsigned u32x4v __attribute__((ext_vector_type(4)));
typedef unsigned u32x2v __attribute__((ext_vector_type(2)));

DI int win_colmap(int n) {
    if (n < 1536 || n >= 2560) return n;
    const int p = n & 31, a = p >> 3, bb = p & 7;
    const int orig = (bb < 4) ? 4 * a + bb : 16 + 4 * a + (bb - 4);
    return (n & ~31) + orig;
}

struct EpiIn {
    static constexpr bool PERM = true, AFTER_DRAIN = false;
    DI bool zero_after(const pg8::Unit&) const { return true; }
    bf16_t *UT, *Q, *K, *V, *G; const float* rope;
    DI void operator()(EPI_ARGS) const {
        const int row0 = u.pm * 256 + wr * 64 + fr;
        const int cb = u.pn * 256 + wc * 32 + 8 * fq;
        const int b = row0 >> 12, t0 = row0 & 4095;
        if (u.pn < 6) {
            const bool odd = fr & 1;
#pragma unroll
            for (int ai = 0; ai < 2; ++ai)
#pragma unroll
                for (int m = 0; m < 4; ++m) {
                    const int t = (t0 + ai * 128 + m * 16) & ~1;
#pragma unroll
                    for (int bj = 0; bj < 2; ++bj)
#pragma unroll
                        for (int n = 0; n < 2; ++n)
#pragma unroll
                            for (int jp = 0; jp < 2; ++jp) {
                                const float a0 = acc[ai][bj][m][n][2 * jp], a1 = acc[ai][bj][m][n][2 * jp + 1];
                                const float rcv = __shfl_xor(odd ? a0 : a1, 1);
                                const unsigned w = odd ? pk2(rcv, a1) : pk2(a0, rcv);
                                const int c = cb + bj * 128 + 4 * n + 2 * jp + (odd ? 1 : 0);
                                *(unsigned*)(UT + ((size_t)(b * 1536 + c) << 12) + t) = w;
                            }
                }
        } else if (u.pn < 10) {
            const bool isq = u.pn < 8;
            const float sc = isq ? 0.18033688011112042f : 1.0f;
#pragma unroll
            for (int ai = 0; ai < 2; ++ai)
#pragma unroll
                for (int m = 0; m < 4; ++m) {
                    const int t = t0 + ai * 128 + m * 16;
                    const int pos = (wc & 1) ? (t & 63) : (t >> 6);
                    const f32x4 cs = *(const f32x4*)(rope + pos * 32 + 4 * fq);
                    const f32x4 sn = *(const f32x4*)(rope + pos * 32 + 16 + 4 * fq);
#pragma unroll
                    for (int bj = 0; bj < 2; ++bj) {
                        const f32x4 x1 = acc[ai][bj][m][0], x2 = acc[ai][bj][m][1];
                        const f32x4 o1 = (x1 * cs - x2 * sn) * sc, o2 = (x1 * sn + x2 * cs) * sc;
                        u32x4v w; w.x = pk2(o1[0], o1[1]); w.y = pk2(o1[2], o1[3]); w.z = pk2(o2[0], o2[1]); w.w = pk2(o2[2], o2[3]);
                        const int c = cb + bj * 128;
                        if (isq) *(u32x4v*)(Q + (size_t)(b * 4096 + t) * 512 + (c - 1536)) = w;
                        else     *(u32x4v*)(K + (size_t)(b * LKV + t) * 512 + (c - 2048)) = w;
                    }
                }
        } else if (u.pn < 12) {
#pragma unroll
            for (int ai = 0; ai < 2; ++ai)
#pragma unroll
                for (int m = 0; m < 4; ++m) {
                    const int t = t0 + ai * 128 + m * 16;
#pragma unroll
                    for (int bj = 0; bj < 2; ++bj) {
                        const f32x4 a0 = acc[ai][bj][m][0], a1 = acc[ai][bj][m][1];
                        u32x4v w; w.x = pk2(a0[0], a0[1]); w.y = pk2(a0[2], a0[3]); w.z = pk2(a1[0], a1[1]); w.w = pk2(a1[2], a1[3]);
                        *(u32x4v*)(V + (size_t)(b * LKV + t) * 512 + (cb + bj * 128 - 2560)) = w;
                    }
                }
        } else {
#pragma unroll
            for (int ai = 0; ai < 2; ++ai)
#pragma unroll
                for (int m = 0; m < 4; ++m) {
                    const int row = row0 + ai * 128 + m * 16;
#pragma unroll
                    for (int bj = 0; bj < 2; ++bj) {
                        float s[8];
#pragma unroll
                        for (int n = 0; n < 2; ++n)
#pragma unroll
                            for (int j = 0; j < 4; ++j) s[4 * n + j] = __builtin_amdgcn_rcpf(1.0f + __builtin_amdgcn_exp2f(-1.4426950408889634f * acc[ai][bj][m][n][j]));
                        u32x4v w; w.x = pk2(s[0], s[1]); w.y = pk2(s[2], s[3]); w.z = pk2(s[4], s[5]); w.w = pk2(s[6], s[7]);
                        *(u32x4v*)(G + (size_t)row * 2048 + (cb + bj * 128 - 3072)) = w;
                    }
                }
        }
    }
};

struct EpiCtx {
    static constexpr bool PERM = true, AFTER_DRAIN = false;
    DI bool zero_after(const pg8::Unit&) const { return true; }
    bf16_t *K, *V;
    DI void operator()(EPI_ARGS) const {
        const int row0 = u.pm * 256 + wr * 64 + fr;
        const int cb = u.pn * 256 + wc * 32 + 8 * fq;
#pragma unroll
        for (int ai = 0; ai < 2; ++ai)
#pragma unroll
            for (int m = 0; m < 4; ++m) {
                const int row = row0 + ai * 128 + m * 16, b = row >> 8, tc = row & 255;
#pragma unroll
                for (int bj = 0; bj < 2; ++bj) {
                    const f32x4 a0 = acc[ai][bj][m][0], a1 = acc[ai][bj][m][1];
                    u32x4v w; w.x = pk2(a0[0], a0[1]); w.y = pk2(a0[2], a0[3]); w.z = pk2(a1[0], a1[1]); w.w = pk2(a1[2], a1[3]);
                    const int c = cb + bj * 128;
                    bf16_t* dst = (u.pn < 2) ? K + (size_t)(b * LKV + SEQ + tc) * 512 + c : V + (size_t)(b * LKV + SEQ + tc) * 512 + (c - 512);
                    *(u32x4v*)dst = w;
                }
            }
    }
};

struct EpiUpM {
    static constexpr bool PERM = true, AFTER_DRAIN = false;
    const bf16_t* G; bf16_t* O;
    DI bool zero_after(const pg8::Unit& u) const { return u.half != 0; }
    DI void mid(f32x4 (&acc)[2][2][4][2], const pg8::Unit& u, int wr, int wc, int fr, int fq) const {
        const int row0 = u.pm * 256 + wr * 64 + fr;
        const int cb = u.pn * 256 + wc * 32 + 8 * fq;
#pragma unroll
        for (int ai = 0; ai < 2; ++ai)
#pragma unroll
            for (int m = 0; m < 4; ++m) {
                const int row = row0 + ai * 128 + m * 16;
#pragma unroll
                for (int bj = 0; bj < 2; ++bj) {
                    const int c = cb + bj * 128;
                    const u32x4v gh = *(const u32x4v*)(G + (size_t)row * 2048 + c);
                    const u32x4v ga = *(const u32x4v*)(G + (size_t)row * 2048 + 1024 + c);
#pragma unroll
                    for (int q = 0; q < 4; ++q) {
                        const float r0 = bf2f(gh[q] & 0xffffu) * __builtin_amdgcn_rcpf(fmaxf(bf2f(ga[q] & 0xffffu), 1e-30f));
                        const float r1 = bf2f(gh[q] >> 16) * __builtin_amdgcn_rcpf(fmaxf(bf2f(ga[q] >> 16), 1e-30f));
                        acc[ai][bj][m][q >> 1][(q & 1) * 2] *= r0; acc[ai][bj][m][q >> 1][(q & 1) * 2 + 1] *= r1;
                    }
                    asm volatile("" : "+v"(acc[ai][bj][m][0]), "+v"(acc[ai][bj][m][1]) :: "memory");
                }
            }
    }
    DI void operator()(EPI_ARGS) const {
        if (u.half == 0) { mid(const_cast<f32x4 (&)[2][2][4][2]>(acc), u, wr, wc, fr, fq); return; }
        const int row0 = u.pm * 256 + wr * 64 + fr;
        const int cb = u.pn * 256 + wc * 32 + 8 * fq;
#pragma unroll
        for (int ai = 0; ai < 2; ++ai)
#pragma unroll
            for (int m = 0; m < 4; ++m) {
                const int row = row0 + ai * 128 + m * 16;
#pragma unroll
                for (int bj = 0; bj < 2; ++bj) {
                    const int c = cb + bj * 128;
                    const u32x4v ga = *(const u32x4v*)(G + (size_t)row * 2048 + 1024 + c);
                    u32x4v w;
#pragma unroll
                    for (int q = 0; q < 4; ++q)
                        w[q] = pk2(acc[ai][bj][m][q >> 1][(q & 1) * 2] * bf2f(ga[q] & 0xffffu), acc[ai][bj][m][q >> 1][(q & 1) * 2 + 1] * bf2f(ga[q] >> 16));
                    *(u32x4v*)(O + (size_t)row * 1024 + c) = w;
                }
            }
    }
};

struct EpiSsq {
    static constexpr bool PERM = true, AFTER_DRAIN = false;
    DI bool zero_after(const pg8::Unit&) const { return true; }
    bf16_t* O; float* ssq;
    DI void operator()(EPI_ARGS) const {
        const int row0 = u.pm * 256 + wr * 64 + fr;
        const int cb = u.pn * 256 + wc * 32 + 8 * fq;
#pragma unroll
        for (int ai = 0; ai < 2; ++ai)
#pragma unroll
            for (int m = 0; m < 4; ++m) {
                const int row = row0 + ai * 128 + m * 16;
                float ss = 0.f;
#pragma unroll
                for (int bj = 0; bj < 2; ++bj) {
                    const f32x4 a0 = acc[ai][bj][m][0], a1 = acc[ai][bj][m][1];
                    ss += a0[0] * a0[0] + a0[1] * a0[1] + a0[2] * a0[2] + a0[3] * a0[3] + a1[0] * a1[0] + a1[1] * a1[1] + a1[2] * a1[2] + a1[3] * a1[3];
                    u32x4v w; w.x = pk2(a0[0], a0[1]); w.y = pk2(a0[2], a0[3]); w.z = pk2(a1[0], a1[1]); w.w = pk2(a1[2], a1[3]);
                    *(u32x4v*)(O + (size_t)row * 1024 + cb + bj * 128) = w;
                }
                ss += __shfl_xor(ss, 16); ss += __shfl_xor(ss, 32);
                if (fq == 0) atomicAdd(ssq + row, ss);
            }
    }
};

struct EpiGU {
    static constexpr bool PERM = true, AFTER_DRAIN = false;
    DI bool zero_after(const pg8::Unit&) const { return true; }
    bf16_t* ACT;
    DI void operator()(EPI_ARGS) const {
        const int row0 = u.pm * 256 + wr * 64 + fr;
        const int cb = u.pn * 128 + wc * 16 + 4 * fq;
#pragma unroll
        for (int ai = 0; ai < 2; ++ai)
#pragma unroll
            for (int m = 0; m < 4; ++m) {
                const int row = row0 + ai * 128 + m * 16;
#pragma unroll
                for (int bj = 0; bj < 2; ++bj) {
                    const f32x4 g = acc[ai][bj][m][0], up = acc[ai][bj][m][1];
                    float r[4];
#pragma unroll
                    for (int j = 0; j < 4; ++j) r[j] = g[j] * __builtin_amdgcn_rcpf(1.0f + __builtin_amdgcn_exp2f(-1.4426950408889634f * g[j])) * up[j];
                    u32x2v w; w.x = pk2(r[0], r[1]); w.y = pk2(r[2], r[3]);
                    *(u32x2v*)(ACT + (size_t)row * DFF + cb + bj * 64) = w;
                }
            }
    }
};

struct HalfOrder {
    pg8::StaticOrder base; int khalf_bytes;
    DI bool next(int i, pg8::Unit& u) const { if (!base.next(i >> 1, u)) return false; u.half = i & 1; u.koff = (i & 1) * khalf_bytes; return true; }
    DI void a_ready(const pg8::Unit&) const {}
    DI void done(const pg8::Unit&) const {}
};

DI void tconv_ld(const Params& P, int it, int tid, f32x4 (&v)[8], bf16_t*& dp, int& K) {
    uchar* ws = P.ws;
    const float* sp; size_t stride; bf16_t* D; int ct, kt, r4;
    const int cl = 4 * (tid & 63), kg = tid >> 6; int kdst = 0;
    if (it < 320) { ct = it >> 4; kt = it & 15; K = 1024; D = (bf16_t*)(ws + WS_WIN); sp = P.w_in; stride = NCOLS;
        const int c4 = ct * 256 + cl; if (c4 < 1536 || c4 >= 2560) r4 = c4; else { const int o = c4 & 31; r4 = (c4 & ~31) + (o < 16 ? 2 * o : 2 * (o - 16) + 4); } }
    else if (it < 352) { const int i2 = it - 320; ct = i2 >> 3; kt = i2 & 7; K = 1024; D = (bf16_t*)(ws + WS_WHY); sp = P.w_hy_up; stride = 1024; r4 = ct * 256 + cl; }
    else if (it < 384) { const int i2 = it - 352; ct = i2 >> 3; kt = i2 & 7; K = 1024; D = (bf16_t*)(ws + WS_WHY); sp = P.w_att_up; stride = 1024; r4 = ct * 256 + cl; kdst = 512; }
    else if (it < 448) { const int i2 = it - 384; ct = i2 >> 4; kt = i2 & 15; K = 1024; D = (bf16_t*)(ws + WS_WOUT); sp = P.w_out; stride = 1024; r4 = ct * 256 + cl; }
    else if (it < 624) { const int i2 = it - 448; ct = i2 >> 4; kt = i2 & 15; K = 1024; D = (bf16_t*)(ws + WS_WGU); sp = P.w_gate; stride = DFF; r4 = 2 * (ct * 256 + cl); }
    else if (it < 800) { const int i2 = it - 624; ct = i2 >> 4; kt = i2 & 15; K = 1024; D = (bf16_t*)(ws + WS_WGU); sp = P.w_up; stride = DFF; r4 = 2 * (ct * 256 + cl) + 4; }
    else { const int i2 = it - 800; ct = i2 / 44; kt = i2 % 44; K = DFF; D = (bf16_t*)(ws + WS_WDN); sp = P.w_down; stride = 1024; r4 = ct * 256 + cl; }
    const int k0 = kt * 64 + kg * 8;
    sp += (size_t)k0 * stride + ct * 256 + cl;
#pragma unroll
    for (int j = 0; j < 8; ++j) v[j] = *(const f32x4*)(sp + (size_t)j * stride);
    dp = D + (size_t)r4 * K + k0 + kdst;
}
DI void tconv_st(const f32x4 (&v)[8], bf16_t* dp, int K) {
#pragma unroll
    for (int q = 0; q < 4; ++q) {
        u32x4v w; w.x = pk2(v[0][q], v[1][q]); w.y = pk2(v[2][q], v[3][q]); w.z = pk2(v[4][q], v[5][q]); w.w = pk2(v[6][q], v[7][q]);
        *(u32x4v*)(dp + (size_t)q * K) = w;
    }
}

constexpr int NCOPY_EARLY = 320, NCOPY_ALL = 976;
DI void tconv_range(const Params& P, int tid, int lo, int hi, int worker, int nworkers) {
    for (int it = lo + worker; it < hi; it += 2 * nworkers) {
        f32x4 va[8], vb[8]; bf16_t *da, *db = nullptr; int Ka, Kb = 0;
        const bool hb = it + nworkers < hi;
        tconv_ld(P, it, tid, va, da, Ka);
        if (hb) tconv_ld(P, it + nworkers, tid, vb, db, Kb);
        tconv_st(va, da, Ka);
        if (hb) tconv_st(vb, db, Kb);
    }
}
DI void phase_prep(const Params& P, LAS uchar* lds) {
    const int tid = threadIdx.x, G = gridDim.x, bid = blockIdx.x;
    const int gtid = bid * 512 + tid, gsz = G * 512;
    uchar* ws = P.ws;
    tconv_range(P, tid, 0, NCOPY_EARLY, bid, G);
    {
        LAS float* sl = (LAS float*)lds;
        LAS float* part = sl + 9216;
        float* ada = (float*)(ws + WS_ADA);
        __syncthreads();
        for (int i = tid; i < 9216; i += 512) { const int r = i >> 10, k = i & 1023; const float v = r < 8 ? P.c[r * 1024 + k] : P.c_ctx[k]; sl[i] = v / (1.0f + expf(-v)); }
        __syncthreads();
        for (int cbk = bid; cbk < 256; cbk += G) {
            if (tid < 504) {
                const int col = tid % 24, kp = tid / 24;
                float a[9];
#pragma unroll
                for (int r = 0; r < 9; ++r) a[r] = 0.f;
#pragma unroll 7
                for (int k = kp; k < 1024; k += 21) {
                    const float w = P.w_ada[(size_t)k * 6144 + cbk * 24 + col];
#pragma unroll
                    for (int r = 0; r < 9; ++r) a[r] += sl[r * 1024 + k] * w;
                }
#pragma unroll
                for (int r = 0; r < 9; ++r) part[kp * 216 + r * 24 + col] = a[r];
            }
            __syncthreads();
            if (tid < 216) {
                float s = 0.f;
                for (int kp = 0; kp < 21; ++kp) s += part[kp * 216 + tid];
                const int r = tid / 24, col = tid % 24;
                ada[r * 6144 + cbk * 24 + col] = s + P.b_ada[cbk * 24 + col];
            }
            __syncthreads();
        }
    }
    {
        LAS float* zb = (LAS float*)lds;
        LAS float* h1 = zb + 17 * 33 + 3;
        LAS float* h2 = h1 + 17 * 64;
        bf16_t* R = (bf16_t*)(ws + WS_R);
        for (int pb = bid; pb < 256; pb += G) {
            const int t0 = pb * 16;
            __syncthreads();
            if (tid < 272) {
                const int pp = tid >> 4, i = tid & 15, t = t0 + pp;
                const float w = (6.283185307179586f / 4096.0f) * (float)t;
                const float fr = 1e-4f + (float)i * ((15.0f - 1e-4f) / 15.0f);
                const float a = fr * w;
                zb[pp * 33 + 1 + i] = __cosf(a); zb[pp * 33 + 17 + i] = -__sinf(a);
                if (i == 0) zb[pp * 33] = (float)t * (1.0f / 4095.0f);
            }
            __syncthreads();
            for (int o = tid; o < 1088; o += 512) {
                const int pp = o >> 6, j = o & 63; float s = P.f_b1[j];
#pragma unroll
                for (int e = 0; e < 33; ++e) s += zb[pp * 33 + e] * P.f_w1[e * 64 + j];
                h1[o] = __sinf(P.f_freq[j] * s);
            }
            __syncthreads();
            for (int o = tid; o < 1088; o += 512) {
                const int pp = o >> 6, j = o & 63; float s = P.f_b2[j];
#pragma unroll 16
                for (int e = 0; e < 64; ++e) s += h1[pp * 64 + e] * P.f_w2[e * 64 + j];
                h2[o] = __sinf(P.f_freq[j] * s);
            }
            __syncthreads();
            const int col0 = tid * 4, n = col0 >> 10, dir = (col0 >> 9) & 1, off = dir ? 0 : 1;
            float acc[16][4];
#pragma unroll
            for (int pp = 0; pp < 16; ++pp)
#pragma unroll
                for (int j = 0; j < 4; ++j) acc[pp][j] = 0.f;
#pragma unroll 2
            for (int k = 0; k < 64; ++k) {
                const f32x4 w = *(const f32x4*)(P.f_w3 + (size_t)k * 2048 + col0);
#pragma unroll
                for (int pp = 0; pp < 16; ++pp) { const float hv = h2[(pp + off) * 64 + k];
#pragma unroll
                    for (int j = 0; j < 4; ++j) acc[pp][j] += hv * w[j]; }
            }
            LAS float* xch = h2 + 17 * 64;
            if (pb == 0) {
                if (dir == 0) {
                    float a0[4] = {0.f, 0.f, 0.f, 0.f};
#pragma unroll 2
                    for (int k = 0; k < 64; ++k) { const f32x4 w = *(const f32x4*)(P.f_w3 + (size_t)k * 2048 + col0); const float hv = h2[k];
#pragma unroll
                        for (int j = 0; j < 4; ++j) a0[j] += hv * w[j]; }
#pragma unroll
                    for (int j = 0; j < 4; ++j) xch[tid * 4 + j] = a0[j] + P.f_b3[col0 + j];
                }
                __syncthreads();
            }
            const float la = -3.0701134573253944f, lb = -15.350567286626973f;
#pragma unroll
            for (int j = 0; j < 4; ++j) {
                const int cch = (col0 + j) & 511;
                const float delta = fabsf(la + (lb - la) * ((float)cch / 511.0f));
                const float b3 = P.f_b3[col0 + j];
                bf16_t* Rc = R + ((size_t)(n * 512 + cch) << 13);
                float v[16];
                float dec = expf(-(float)(t0 + off) * (1.0f / 4095.0f) * delta); const float rr = expf(-delta * (1.0f / 4095.0f));
#pragma unroll
                for (int pp = 0; pp < 16; ++pp) { v[pp] = (acc[pp][j] + b3) * dec; dec *= rr; }
                if (dir == 0) {
                    if (pb == 255) v[15] = 0.f;
                    u32x4v w0, w1;
#pragma unroll
                    for (int i = 0; i < 4; ++i) { w0[i] = pk2(v[15 - 2 * i], v[14 - 2 * i]); w1[i] = pk2(v[7 - 2 * i], v[6 - 2 * i]); }
                    *(u32x4v*)(Rc + 4080 - t0) = w0; *(u32x4v*)(Rc + 4088 - t0) = w1;
                } else {
                    if (pb == 0) v[0] = xch[(tid - 128) * 4 + j];
                    u32x4v w0, w1;
#pragma unroll
                    for (int i = 0; i < 4; ++i) { w0[i] = pk2(v[2 * i], v[2 * i + 1]); w1[i] = pk2(v[8 + 2 * i], v[9 + 2 * i]); }
                    *(u32x4v*)(Rc + 4096 + t0) = w0; *(u32x4v*)(Rc + 4104 + t0) = w1;
                }
            }
        }
    }
    {
        float* rope = (float*)(ws + WS_ROPE);
        for (int i = gtid; i < 1024; i += gsz) {
            const int pos = i >> 4, f = i & 15;
            const float inv = powf(10000.0f, -(float)f / 16.0f), ang = (float)pos * inv;
            rope[pos * 32 + f] = cosf(ang); rope[pos * 32 + 16 + f] = sinf(ang);
        }
        if (gtid < 64) {
            float s1 = P.lq1[gtid] * P.lk1[gtid], s2 = P.lq2[gtid] * P.lk2[gtid];
            s1 = wave_sum(s1); s2 = wave_sum(s2);
            if (gtid == 0) ((float*)(ws + WS_MISC))[0] = expf(s1) - expf(s2) + 0.2f;
        }
        float* ssq = (float*)(ws + WS_SSQ);
        for (int i = gtid; i < 2 * NTOK; i += gsz) ssq[i] = 0.f;
    }
}

DI f32x4 ld_bf4(const bf16_t* p) { const u32x2v w = *(const u32x2v*)p; return (f32x4){bf2f(w.x & 0xffffu), bf2f(w.x >> 16), bf2f(w.y & 0xffffu), bf2f(w.y >> 16)}; }
DI void st_bf4(bf16_t* p, const f32x4 h) { u32x2v w; w.x = pk2(h[0], h[1]); w.y = pk2(h[2], h[3]); *(u32x2v*)p = w; }
DI float sq4(const f32x4 v) { return v[0] * v[0] + v[1] * v[1] + v[2] * v[2] + v[3] * v[3]; }
constexpr int RW = 4;
DI void phase_norm1(const Params& P) {
    const int lane = threadIdx.x & 63, gw = blockIdx.x * 8 + (threadIdx.x >> 6), nw = gridDim.x * 8;
    const float* ada = (const float*)(P.ws + WS_ADA);
    bf16_t* H = (bf16_t*)(P.ws + WS_A); bf16_t* HC = (bf16_t*)(P.ws + WS_HC);
    for (int row0 = gw * RW; row0 < NTOK + NCTX; row0 += nw * RW) {
        const bool lat = row0 < NTOK;
        const float* src = lat ? P.x + (size_t)row0 * 1024 : P.ctx + (size_t)(row0 - NTOK) * 1024;
        const float* ar = ada + (lat ? (row0 >> 12) : 8) * 6144;
        bf16_t* dst = lat ? H + (size_t)row0 * 1024 : HC + (size_t)(row0 - NTOK) * 1024;
        f32x4 v[RW][4]; float ss[RW];
#pragma unroll
        for (int r = 0; r < RW; ++r)
#pragma unroll
            for (int i = 0; i < 4; ++i) v[r][i] = __builtin_nontemporal_load((const f32x4*)(src + r * 1024 + i * 256 + lane * 4));
        f32x4 g[4], sh[4], sc[4];
#pragma unroll
        for (int i = 0; i < 4; ++i) { const int col = i * 256 + lane * 4; g[i] = *(const f32x4*)(P.g_mix_pre + col); sh[i] = *(const f32x4*)(ar + col); sc[i] = *(const f32x4*)(ar + 1024 + col); }
#pragma unroll
        for (int r = 0; r < RW; ++r) { ss[r] = sq4(v[r][0]) + sq4(v[r][1]) + sq4(v[r][2]) + sq4(v[r][3]); ss[r] = wave_sum(ss[r]); }
#pragma unroll
        for (int r = 0; r < RW; ++r) {
            const float rstd = rsqrtf(ss[r] * (1.0f / 1024.0f) + EPSN);
#pragma unroll
            for (int i = 0; i < 4; ++i) st_bf4(dst + r * 1024 + i * 256 + lane * 4, v[r][i] * rstd * g[i] * (sc[i] + 1.0f) + sh[i]);
        }
    }
}

DI void phase_mid(const Params& P) {
    const int lane = threadIdx.x & 63, gw = blockIdx.x * 8 + (threadIdx.x >> 6), nw = gridDim.x * 8;
    const float* ada = (const float*)(P.ws + WS_ADA);
    const bf16_t* MX = (const bf16_t*)(P.ws + WS_C); const float* ssq1 = (const float*)(P.ws + WS_SSQ);
    bf16_t* HF = (bf16_t*)(P.ws + WS_A);
    for (int row0 = gw * RW; row0 < NTOK; row0 += nw * RW) {
        const float* ar = ada + (row0 >> 12) * 6144;
        f32x4 v[RW][4], mv[RW][4]; float rs1[RW], ss[RW];
#pragma unroll
        for (int r = 0; r < RW; ++r) {
            rs1[r] = ssq1[row0 + r];
#pragma unroll
            for (int i = 0; i < 4; ++i) { const size_t o = (size_t)(row0 + r) * 1024 + i * 256 + lane * 4; v[r][i] = __builtin_nontemporal_load((const f32x4*)(P.x + o)); mv[r][i] = ld_bf4(MX + o); }
        }
#pragma unroll
        for (int r = 0; r < RW; ++r) {
            const float rstd1 = rsqrtf(rs1[r] * (1.0f / 1024.0f) + EPSN);
            ss[r] = 0.f;
#pragma unroll
            for (int i = 0; i < 4; ++i) {
                const int col = i * 256 + lane * 4;
                const f32x4 gp = *(const f32x4*)(P.g_mix_post + col), g1 = *(const f32x4*)(ar + 2048 + col);
                v[r][i] = v[r][i] + g1 * (mv[r][i] * rstd1 * gp);
                ss[r] += sq4(v[r][i]);
            }
            ss[r] = wave_sum(ss[r]);
        }
#pragma unroll
        for (int r = 0; r < RW; ++r) {
            const float rstd = rsqrtf(ss[r] * (1.0f / 1024.0f) + EPSN);
#pragma unroll
            for (int i = 0; i < 4; ++i) {
                const int col = i * 256 + lane * 4;
                const f32x4 g = *(const f32x4*)(P.g_ffn_pre + col), sh = *(const f32x4*)(ar + 3072 + col), sc = *(const f32x4*)(ar + 4096 + col);
                st_bf4(HF + (size_t)(row0 + r) * 1024 + col, v[r][i] * rstd * g * (sc + 1.0f) + sh);
            }
        }
    }
}

DI void phase_final(const Params& P) {
    constexpr int R9 = 2;
    const int lane = threadIdx.x & 63, gw = blockIdx.x * 8 + (threadIdx.x >> 6), nw = gridDim.x * 8;
    const float* ada = (const float*)(P.ws + WS_ADA);
    const bf16_t* MX = (const bf16_t*)(P.ws + WS_C); const bf16_t* F = (const bf16_t*)(P.ws + WS_C + (size_t)NTOK * 1024 * 2);
    const float* ssq1 = (const float*)(P.ws + WS_SSQ); const float* ssq2 = ssq1 + NTOK;
    for (int row0 = gw * R9; row0 < NTOK; row0 += nw * R9) {
        const float* ar = ada + (row0 >> 12) * 6144;
        f32x4 v[R9][4], mv[R9][4], fv[R9][4]; float rs1[R9], rs2[R9];
#pragma unroll
        for (int r = 0; r < R9; ++r) {
            rs1[r] = ssq1[row0 + r]; rs2[r] = ssq2[row0 + r];
#pragma unroll
            for (int i = 0; i < 4; ++i) { const size_t o = (size_t)(row0 + r) * 1024 + i * 256 + lane * 4; v[r][i] = __builtin_nontemporal_load((const f32x4*)(P.x + o)); mv[r][i] = ld_bf4(MX + o); fv[r][i] = ld_bf4(F + o); }
        }
#pragma unroll
        for (int r = 0; r < R9; ++r) {
            const float rstd1 = rsqrtf(rs1[r] * (1.0f / 1024.0f) + EPSN), rstd2 = rsqrtf(rs2[r] * (1.0f / 1024.0f) + EPSN);
#pragma unroll
            for (int i = 0; i < 4; ++i) {
                const int col = i * 256 + lane * 4;
                const f32x4 gp1 = *(const f32x4*)(P.g_mix_post + col), g1 = *(const f32x4*)(ar + 2048 + col);
                const f32x4 gp = *(const f32x4*)(P.g_ffn_post + col), g2 = *(const f32x4*)(ar + 5120 + col);
                const f32x4 x1 = v[r][i] + g1 * (mv[r][i] * rstd1 * gp1);
                __builtin_nontemporal_store(x1 + g2 * (fv[r][i] * rstd2 * gp), (f32x4*)(P.out + (size_t)(row0 + r) * 1024 + col));
            }
        }
    }
}

DI float xhalf_max(float m) { auto rr = __builtin_amdgcn_permlane32_swap(__float_as_uint(m), __float_as_uint(m), false, false); return fmaxf(__uint_as_float(rr[0]), __uint_as_float(rr[1])); }
DI float xhalf_sum(float m) { auto rr = __builtin_amdgcn_permlane32_swap(__float_as_uint(m), __float_as_uint(m), false, false); return __uint_as_float(rr[0]) + __uint_as_float(rr[1]); }
DI void glds16(const void* gsrc, unsigned lds_dst) { unsigned keep;
    asm volatile("s_mov_b32 %0, m0\n\ts_mov_b32 m0, %2\n\ts_nop 0\n\tglobal_load_lds_dwordx4 %1, off\n\ts_mov_b32 m0, %0" : "=&s"(keep) : "v"(gsrc), "s"(lds_dst) : "memory"); }
DI void attn_unit(const Params& P, LAS uchar* lds, int b, int h, int qb, float lam) {
    int tid_ = threadIdx.x; asm volatile("" : "+v"(tid_));
    const int tid = tid_, lane = tid & 63, wid = __builtin_amdgcn_readfirstlane(tid >> 6), map = wid >> 2, wq = wid & 3, r32 = lane & 31, hi = lane >> 5;
    const bf16_t* Qg = (const bf16_t*)(P.ws + WS_Q) + (size_t)(b * 4096 + qb * 128 + wq * 32 + r32) * 512 + h * 128 + map * 64 + hi * 8;
    bf16x8 qf[4];
#pragma unroll
    for (int s = 0; s < 4; ++s) qf[s] = *(const bf16x8*)(Qg + 16 * s);
    constexpr unsigned KS = 16384, VS0 = 3 * KS, VS = 16384;
    constexpr size_t TILE = (size_t)64 * 512;
    const bf16_t* kg[2]; const bf16_t* vg[2];
#pragma unroll
    for (int i = 0; i < 2; ++i) {
        const int j = 2 * wid + i;
        const int krow = 8 * (j & 7) + (lane >> 3), kc = (lane & 7) ^ ((krow >> 1) & 7);
        kg[i] = (const bf16_t*)(P.ws + WS_K) + (size_t)(b * LKV + krow) * 512 + h * 128 + (j >> 3) * 64 + kc * 8;
        const int vrow = 4 * j + (lane >> 4), vc = (lane & 15) ^ (4 * (vrow & 3));
        vg[i] = (const bf16_t*)(P.ws + WS_V) + (size_t)(b * LKV + vrow) * 512 + h * 128 + vc * 8;
    }
    const unsigned ldsw = (unsigned)wid * 2048u;
    const unsigned lds0 = (unsigned)(size_t)lds;
#define AT_DMA_K(T, SLOT) do { _Pragma("unroll") for (int i_ = 0; i_ < 2; ++i_) \
        glds16(kg[i_] + (size_t)(T) * TILE, (unsigned)__builtin_amdgcn_readfirstlane(lds0 + (SLOT) + ldsw + i_ * 1024)); } while (0)
#define AT_DMA_V(T, SLOT) do { _Pragma("unroll") for (int i_ = 0; i_ < 2; ++i_) \
        glds16(vg[i_] + (size_t)(T) * TILE, (unsigned)__builtin_amdgcn_readfirstlane(lds0 + (SLOT) + ldsw + i_ * 1024)); } while (0)
    unsigned kq[4], vq[4];
    { const int x = (r32 >> 1) & 7, q = (lane & 15) >> 2, p = lane & 3, blk = (lane >> 4) & 1;
#pragma unroll
      for (int s = 0; s < 4; ++s) kq[s] = map * 8192 + r32 * 128 + (((2 * s + hi) ^ x) << 4);
#pragma unroll
      for (int d = 0; d < 4; ++d) vq[d] = (4 * hi + q) * 256 + ((4 * (d ^ q) + 2 * blk + (p >> 1)) << 4) + 8 * (p & 1); }
#define AT_QK(KSLOT) do { _Pragma("unroll") for (int s = 0; s < 4; ++s) { \
        const bf16x8 a0 = *(LAS const bf16x8*)(lds + (KSLOT) + kq[s]); const bf16x8 a1 = *(LAS const bf16x8*)(lds + (KSLOT) + kq[s] + 4096); \
        if (s == 0) { st0 = MFMA32(a0, qf[0], negm); st1 = MFMA32(a1, qf[0], negm); } else { st0 = MFMA32(a0, qf[s], st0); st1 = MFMA32(a1, qf[s], st1); } } } while (0)
#define AT_PV(VSLOT) do { _Pragma("unroll") for (int ks = 0; ks < 4; ++ks) _Pragma("unroll") for (int d = 0; d < 4; ++d) { \
        const s16x4 lo = vtr(lds + (VSLOT) + vq[d] + (16 * ks) * 256); const s16x4 hh = vtr(lds + (VSLOT) + vq[d] + (16 * ks + 8) * 256); \
        const bf16x8 va = __builtin_shufflevector(lo, hh, 0, 1, 2, 3, 4, 5, 6, 7); ot[d] = MFMA32(va, pb[ks], ot[d]); } } while (0)
#define AT_ROWMAX(mx) do { float a_ = fmaxf(st0[0], st1[0]), b_ = fmaxf(st0[1], st1[1]); _Pragma("unroll") for (int r = 2; r < 16; r += 2) { a_ = fmaxf(a_, fmaxf(st0[r], st1[r])); b_ = fmaxf(b_, fmaxf(st0[r + 1], st1[r + 1])); } mx = xhalf_max(fmaxf(a_, b_)); } while (0)
#define AT_EXPS(PB) do { float s0_ = 0.f, s1_ = 0.f; _Pragma("unroll") for (int r = 0; r < 16; ++r) { st0[r] = __builtin_amdgcn_exp2f(st0[r]); st1[r] = __builtin_amdgcn_exp2f(st1[r]); s0_ += st0[r]; s1_ += st1[r]; } \
        lsum += s0_ + s1_; PB[0] = pack8(st0, 0); PB[1] = pack8(st0, 1); PB[2] = pack8(st1, 0); PB[3] = pack8(st1, 1); } while (0)
    __syncthreads();
    AT_DMA_K(0, 0); AT_DMA_K(1, KS); AT_DMA_V(0, VS0); AT_DMA_K(2, 2 * KS); AT_DMA_V(1, VS0 + VS);
    asm volatile("s_waitcnt vmcnt(0)" ::: "memory"); __syncthreads();
    f32x16 ot[4], st0, st1, negm;
#pragma unroll
    for (int r = 0; r < 16; ++r) { negm[r] = 0.f; ot[0][r] = 0.f; ot[1][r] = 0.f; ot[2][r] = 0.f; ot[3][r] = 0.f; }
    float mref, lsum = 0.f;
    bf16x8 pb[4];
    AT_QK(0);
    { float mx; AT_ROWMAX(mx); mref = mx;
#pragma unroll
      for (int r = 0; r < 16; ++r) { st0[r] -= mx; st1[r] -= mx; negm[r] = -mx; }
      AT_EXPS(pb); }
    AT_QK(KS);
    __syncthreads();
    unsigned vs_prev = VS0, vs_cur = VS0 + VS, vs_next = VS0 + 2 * VS;
    unsigned k_rd = 2 * KS, k_wr = 0;
    for (int t = 1; t < 68; ++t) {
        const unsigned kcur = k_rd, kwr = k_wr;
        if (t + 2 < 68) AT_DMA_K(t + 2, kwr);
        if (t + 1 < 68) AT_DMA_V(t + 1, vs_next);
        float mx; AT_ROWMAX(mx);
        AT_PV(vs_prev);
        if (__any(mx > 8.0f)) {
            const float dl = fmaxf(mx, 0.f), alpha = __builtin_amdgcn_exp2f(-dl);
            mref += dl; lsum *= alpha;
#pragma unroll
            for (int r = 0; r < 16; ++r) { st0[r] -= dl; st1[r] -= dl; negm[r] = -mref; ot[0][r] *= alpha; ot[1][r] *= alpha; ot[2][r] *= alpha; ot[3][r] *= alpha; }
        }
        AT_EXPS(pb);
        if (t + 1 < 68) AT_QK(kcur);
        asm volatile("s_waitcnt vmcnt(0)" ::: "memory"); __syncthreads();
        { const unsigned tmp_ = vs_prev; vs_prev = vs_cur; vs_cur = vs_next; vs_next = tmp_; }
        k_rd = k_wr; k_wr = (k_wr == 2 * KS) ? 0u : k_wr + KS;
    }
    AT_PV(vs_prev);
    __syncthreads();
#undef AT_DMA_K
#undef AT_DMA_V
#undef AT_QK
#undef AT_PV
#undef AT_ROWMAX
#undef AT_EXPS
    const float l = xhalf_sum(lsum);
    const float inv = 1.0f / l;
    LAS float* cbuf = (LAS float*)lds;
    if (map == 1) {
        const float sc = inv * lam;
#pragma unroll
        for (int d = 0; d < 4; ++d)
#pragma unroll
            for (int r = 0; r < 16; ++r) cbuf[(wq * 128 + 32 * d + crow(r, hi)) * 32 + r32] = ot[d][r] * sc;
    }
    __syncthreads();
    if (map == 0) {
        float ss = 0.f;
#pragma unroll
        for (int d = 0; d < 4; ++d)
#pragma unroll
            for (int r = 0; r < 16; ++r) { const float o = ot[d][r] * inv - cbuf[(wq * 128 + 32 * d + crow(r, hi)) * 32 + r32]; ot[d][r] = o; ss += o * o; }
        ss = xhalf_sum(ss);
        const float rs = rsqrtf(ss * (1.0f / 128.0f) + EPSN) * 0.8f;
        bf16_t* dst = (bf16_t*)(P.ws + WS_D) + (size_t)(b * 4096 + qb * 128 + wq * 32 + r32) * 1024 + 512 + h * 128;
#pragma unroll
        for (int d = 0; d < 4; ++d)
#pragma unroll
            for (int g = 0; g < 4; ++g) {
                const int d0 = 32 * d + 8 * g + 4 * hi;
                const f32x4 gg = *(const f32x4*)(P.subln_g + d0);
                u32x2v w; w.x = pk2(ot[d][4 * g] * rs * gg[0], ot[d][4 * g + 1] * rs * gg[1]); w.y = pk2(ot[d][4 * g + 2] * rs * gg[2], ot[d][4 * g + 3] * rs * gg[3]);
                *(u32x2v*)(dst + d0) = w;
            }
    }
}

constexpr int UPITCH = 5000, UPAD = 448;
constexpr unsigned HY_RE = 8 * UPITCH * 2, HY_RO = HY_RE + 16384 + 64;
DI void hyena_load_filter(const bf16_t* Rg, LAS uchar* lds, int tid) {
    for (int v = tid; v < 1024; v += 512) {
        const u32x4v a = *(const u32x4v*)(Rg + 8 * v);
        *(LAS u32x4v*)(lds + HY_RE + 16 * v) = a;
        const unsigned nx = (v < 1023) ? (unsigned)Rg[8 * v + 8] : 0u;
        u32x4v o; o.x = (a.x >> 16) | (a.y << 16); o.y = (a.y >> 16) | (a.z << 16); o.z = (a.z >> 16) | (a.w << 16); o.w = (a.w >> 16) | (nx << 16);
        *(LAS u32x4v*)(lds + HY_RO + 16 * v) = o;
    }
}
DI void hyena_unit(const Params& P, LAS uchar* lds, int c, int slot) {
    int tid_ = threadIdx.x; asm volatile("" : "+v"(tid_));
    const int tid = tid_, lane = tid & 63, w = __builtin_amdgcn_readfirstlane(tid >> 6), r32 = lane & 31, hi = lane >> 5;
    LAS bf16_t* U = (LAS bf16_t*)lds;
    const bf16_t* UT = (const bf16_t*)(P.ws + WS_UT);
    const bf16_t* R = (const bf16_t*)(P.ws + WS_R);
    bf16_t* scr = (bf16_t*)(P.ws + WS_A) + ((size_t)blockIdx.x * 2 + slot) * 32768;
    __syncthreads();
#pragma unroll 1
    for (int i = tid; i < 904; i += 512) {
        const int bb = i / 113, o = i % 113;
        const u32x4v z4 = {0u, 0u, 0u, 0u};
        *(LAS u32x4v*)(lds + bb * (UPITCH * 2) + (o < 56 ? o * 16 : (UPAD + 4096) * 2 + (o - 56) * 16)) = z4;
    }
    {
        const float w0 = P.hy_conv_w[c], w1 = P.hy_conv_w[1536 + c], w2 = P.hy_conv_w[3072 + c], cb = P.hy_conv_b[c];
#pragma unroll
        for (int i = 0; i < 8; ++i) {
            const int ch = tid + 512 * i, bb = ch >> 9, t8 = (ch & 511) * 8;
            const bf16_t* src = UT + ((size_t)(bb * 1536 + c) << 12) + t8;
            const u32x4v raw = *(const u32x4v*)src;
            float f[10];
            f[0] = t8 > 0 ? bf2f(src[-1]) : 0.f; f[9] = t8 + 8 < 4096 ? bf2f(src[8]) : 0.f;
#pragma unroll
            for (int q = 0; q < 4; ++q) { f[1 + 2 * q] = bf2f(raw[q] & 0xffffu); f[2 + 2 * q] = bf2f(raw[q] >> 16); }
            float o[8];
#pragma unroll
            for (int e = 0; e < 8; ++e) o[e] = w0 * f[e] + w1 * f[e + 1] + w2 * f[e + 2] + cb;
            u32x4v pw; pw.x = pk2(o[0], o[1]); pw.y = pk2(o[2], o[3]); pw.z = pk2(o[4], o[5]); pw.w = pk2(o[6], o[7]);
            *(LAS u32x4v*)(lds + (bb * UPITCH + UPAD + t8) * 2) = pw;
        }
    }
    hyena_load_filter(R + ((size_t)c << 13), lds, tid);
    __syncthreads();
    const int Iloc = r32 >> 3, bb = r32 & 7;
    const int ubase = (bb * UPITCH + UPAD + 64 * Iloc + 8 * hi) * 2;
    for (int ord = 0; ord < 2; ++ord) {
        f32x16 acc[2][2];
#pragma unroll
        for (int a = 0; a < 2; ++a)
#pragma unroll
            for (int m = 0; m < 2; ++m)
#pragma unroll
                for (int r = 0; r < 16; ++r) acc[a][m][r] = 0.f;
#define HY_LA(D, AF) do { const int q00 = 4096 - 64 * (D) - r32 + 8 * hi; \
            const unsigned abase = (q00 & 1) ? HY_RO + (unsigned)((q00 - 1) >> 1) * 4u : HY_RE + (unsigned)(q00 >> 1) * 4u; \
            _Pragma("unroll") for (int i = 0; i < 6; ++i) { u32x4v t_; \
                _Pragma("unroll") for (int e = 0; e < 4; ++e) t_[e] = *(LAS const unsigned*)(lds + abase + (8 * (i - 2) + e) * 4); AF[i] = __builtin_bit_cast(bf16x8, t_); } } while (0)
#define HY_LB(D, NBL, BF) do { _Pragma("unroll") for (int s = 0; s < 4; ++s) BF[s] = *(LAS const bf16x8*)(lds + ubase + (8 * w + 4 * (NBL) - (D)) * 128 + s * 32); } while (0)
#define HY_M(AF, BF, NBL) do { _Pragma("unroll") for (int s = 0; s < 4; ++s) { acc[NBL][0] = MFMA32(AF[s + 2], BF[s], acc[NBL][0]); acc[NBL][1] = MFMA32(AF[s], BF[s], acc[NBL][1]); } } while (0)
        {
            const int d0 = 8 * w - 63, d1 = 8 * w + 7;
            bf16x8 afA[6], afB[6], bf0[4], bf1[4];
            HY_LA(d0, afA); HY_LB(d0, 0, bf0);
#pragma unroll 1
            for (int d = d0; d < d1; d += 2) {
                const int dn = d + 2 <= d1 ? d + 2 : d1;
                HY_LB(d, 1, bf1); HY_M(afA, bf0, 0); HY_LA(d + 1, afB); HY_LB(d + 1, 0, bf0); HY_M(afA, bf1, 1);
                HY_LB(d + 1, 1, bf1); HY_M(afB, bf0, 0); HY_LA(dn, afA); HY_LB(dn, 0, bf0); HY_M(afB, bf1, 1);
            }
            HY_LB(d1, 1, bf1); HY_M(afA, bf0, 0); HY_M(afA, bf1, 1);
        }
#undef HY_LA
#undef HY_LB
#undef HY_M
        const int xch = 512 * (ord + 1) + c;
        const float w0 = P.hy_conv_w[xch], w1 = P.hy_conv_w[1536 + xch], w2 = P.hy_conv_w[3072 + xch], cb = P.hy_conv_b[xch];
        const float dbias = P.hy_bias[ord * 512 + c];
        const bf16_t* xg = UT + ((size_t)(bb * 1536 + xch) << 12);
        unsigned zp[2][2][8];
#pragma unroll
        for (int nbl = 0; nbl < 2; ++nbl)
#pragma unroll
            for (int mb = 0; mb < 2; ++mb) {
                const int base = 64 * (8 * w + 4 * nbl + Iloc) + 32 * mb;
                u32x4v W[4];
#pragma unroll
                for (int g = 0; g < 4; ++g) W[g] = *(const u32x4v*)(xg + base + 8 * g);
                const int eidx = hi ? base + 32 : base - 1;
                const unsigned ebits = (eidx >= 0 && eidx < 4096) ? (unsigned)xg[eidx] : 0u;
#pragma unroll
                for (int g = 0; g < 4; ++g) {
                    const int t4 = base + 8 * g + 4 * hi;
                    const u32x2v uu = *(LAS const u32x2v*)(lds + (bb * UPITCH + UPAD + t4) * 2);
                    const unsigned pd3 = (g > 0) ? W[g > 0 ? g - 1 : 0][3] : (ebits << 16), nd0 = (g < 3) ? W[g < 3 ? g + 1 : 3][0] : ebits;
                    const unsigned dA = hi ? W[g][1] : pd3, dB = hi ? W[g][2] : W[g][0], dC = hi ? W[g][3] : W[g][1], dD = hi ? nd0 : W[g][2];
                    float f[6];
                    f[0] = bf2f(dA >> 16); f[1] = bf2f(dB & 0xffffu); f[2] = bf2f(dB >> 16); f[3] = bf2f(dC & 0xffffu); f[4] = bf2f(dC >> 16); f[5] = bf2f(dD & 0xffffu);
                    const float u0 = bf2f(uu.x & 0xffffu), u1 = bf2f(uu.x >> 16), u2 = bf2f(uu.y & 0xffffu), u3 = bf2f(uu.y >> 16);
                    const float z0 = (w0 * f[0] + w1 * f[1] + w2 * f[2] + cb) * (acc[nbl][mb][4 * g + 0] + dbias * u0);
                    const float z1 = (w0 * f[1] + w1 * f[2] + w2 * f[3] + cb) * (acc[nbl][mb][4 * g + 1] + dbias * u1);
                    const float z2 = (w0 * f[2] + w1 * f[3] + w2 * f[4] + cb) * (acc[nbl][mb][4 * g + 2] + dbias * u2);
                    const float z3 = (w0 * f[3] + w1 * f[4] + w2 * f[5] + cb) * (acc[nbl][mb][4 * g + 3] + dbias * u3);
                    asm volatile("" ::: "memory");
                    if (ord == 0) { zp[nbl][mb][2 * g] = pk2(z0, z1); zp[nbl][mb][2 * g + 1] = pk2(z2, z3); }
                    else {
                        u32x2v pz; pz.x = pk2(z0, z1); pz.y = pk2(z2, z3);
                        *(u32x2v*)(scr + bb * 4096 + t4) = pz;
                    }
                }
            }
        if (ord == 0) {
            __syncthreads();
#pragma unroll
            for (int nbl = 0; nbl < 2; ++nbl)
#pragma unroll
                for (int mb = 0; mb < 2; ++mb)
#pragma unroll
                    for (int g = 0; g < 4; ++g) {
                        const int t4 = 64 * (8 * w + 4 * nbl + Iloc) + 32 * mb + 8 * g + 4 * hi;
                        u32x2v zz; zz.x = zp[nbl][mb][2 * g]; zz.y = zp[nbl][mb][2 * g + 1];
                        *(LAS u32x2v*)(lds + (bb * UPITCH + UPAD + t4) * 2) = zz;
                    }
            hyena_load_filter(R + ((size_t)(512 + c) << 13), lds, tid);
            __syncthreads();
        }
    }
}

DI void hyena_flush(const Params& P, int c0) {
    asm volatile("s_waitcnt vmcnt(0)" ::: "memory");
    __syncthreads();
    const unsigned long long* sa = (const unsigned long long*)((const bf16_t*)(P.ws + WS_A) + (size_t)blockIdx.x * 2 * 32768);
    const unsigned long long* sb = sa + 8192;
    bf16_t* Z = (bf16_t*)(P.ws + WS_D);
#pragma unroll 4
    for (int i = threadIdx.x; i < 8192; i += 512) {
        const unsigned long long a = __hip_atomic_load(sa + i, __ATOMIC_RELAXED, __HIP_MEMORY_SCOPE_AGENT), b = __hip_atomic_load(sb + i, __ATOMIC_RELAXED, __HIP_MEMORY_SCOPE_AGENT);
        const unsigned a0 = (unsigned)a, a1 = (unsigned)(a >> 32), b0 = (unsigned)b, b1 = (unsigned)(b >> 32);
        unsigned* zm = (unsigned*)(Z + (size_t)(4 * i) * 1024 + c0);
        zm[0] = (a0 & 0xffffu) | (b0 << 16); zm[512] = (a0 >> 16) | (b0 & 0xffff0000u); zm[1024] = (a1 & 0xffffu) | (b1 << 16); zm[1536] = (a1 >> 16) | (b1 & 0xffff0000u);
    }
    __syncthreads();
}

#define XB_TMO      128
#define XB_XCNT(j)  (256  + 64 * (j))
#define XB_XSUB(j)  (1280 + 64 * (j))
#define XB_XGEN(j)  (2304 + 64 * (j))
#define XB_TOP      3328
#define XB_TOPGEN   3392
#define XCD_BAR_WORDS 3456
#define XB_SPIN_CAP (1u << 18)

__device__ __forceinline__ unsigned xb_ld(unsigned* p)              { return __hip_atomic_load(p, __ATOMIC_RELAXED, __HIP_MEMORY_SCOPE_AGENT); }
__device__ __forceinline__ unsigned xb_add(unsigned* p, unsigned v) { return __hip_atomic_fetch_add(p, v, __ATOMIC_RELAXED, __HIP_MEMORY_SCOPE_AGENT); }
__device__ __forceinline__ unsigned xb_xcc_id() { return (unsigned)__builtin_amdgcn_s_getreg((3 << 11) | 20) & 0xFu; }
#define XB_SPIN(cond, bar) do { unsigned _sp = 0; while (cond) { __builtin_amdgcn_s_sleep(1); \
    if ((++_sp & 255u) == 0u) { if (xb_ld(&(bar)[XB_TMO])) break; if (_sp > XB_SPIN_CAP) { atomicAdd(&(bar)[XB_TMO], 1u); break; } } } } while (0)

struct XcdBarrier {
    unsigned* bar; unsigned x;
    volatile LAS unsigned* st;
};

__device__ __forceinline__ XcdBarrier xcd_barrier_post(unsigned* bar, volatile LAS unsigned* st) {
    XcdBarrier b; b.bar = bar; b.x = xb_xcc_id(); b.st = st;
    if (threadIdx.x == 0) (void)xb_add(&bar[XB_XCNT(b.x)], 1u);
    return b;
}
__device__ __forceinline__ void xcd_barrier_complete(unsigned* bar, unsigned x, unsigned& nloc, unsigned& nx) {
    const unsigned G = gridDim.x * gridDim.y * gridDim.z;
    unsigned sum, cnt, mine, sp = 0u;
    for (;;) {
        sum = 0u; cnt = 0u; mine = 0u;
#pragma unroll
        for (unsigned j = 0; j < 16; ++j) { const unsigned c = xb_ld(&bar[XB_XCNT(j)]); sum += c; cnt += (c > 0u) ? 1u : 0u; mine = (j == x) ? c : mine; }
        if (sum == G) break;
        __builtin_amdgcn_s_sleep(1);
        if ((++sp & 255u) == 0u) { if (xb_ld(&bar[XB_TMO])) break; if (sp > XB_SPIN_CAP) { atomicAdd(&bar[XB_TMO], 1u); break; } }
    }
    nloc = mine > 0u ? mine : 1u; nx = cnt > 0u ? cnt : 1u;
}

__device__ __forceinline__ void xcd_barrier(const XcdBarrier& b) {
    asm volatile("s_waitcnt vmcnt(0)" ::: "memory");
    __syncthreads();
    if (threadIdx.x == 0) {
        unsigned* bar = b.bar;
        __builtin_amdgcn_s_waitcnt(0);
        unsigned nloc = b.st[0], nx = b.st[1];
        if (nloc == 0u) { xcd_barrier_complete(bar, b.x, nloc, nx); b.st[0] = nloc; b.st[1] = nx; }
        const unsigned old = xb_add(&bar[XB_XSUB(b.x)], 1u);
        const unsigned gen = old / nloc;
        if (old + 1u == (gen + 1u) * nloc) {
            __builtin_amdgcn_fence(__ATOMIC_RELEASE, "agent");
            asm volatile("s_waitcnt vmcnt(0)" ::: "memory");
            const unsigned og = xb_add(&bar[XB_TOP], 1u);
            const unsigned tg = og / nx;
            if (og + 1u == (tg + 1u) * nx) xb_add(&bar[XB_TOPGEN], 1u);
            else XB_SPIN(xb_ld(&bar[XB_TOPGEN]) == tg, bar);
            __builtin_amdgcn_fence(__ATOMIC_ACQUIRE, "agent");
            xb_add(&bar[XB_XGEN(b.x)], 1u);
            asm volatile("s_waitcnt vmcnt(0)" ::: "memory");
        } else {
            XB_SPIN(xb_ld(&bar[XB_XGEN(b.x)]) == gen, bar);
            __builtin_amdgcn_fence(__ATOMIC_ACQUIRE, "agent");
            asm volatile("s_waitcnt vmcnt(0)" ::: "memory");
        }
    }
    __syncthreads();
}


__global__ void __launch_bounds__(512, 2) mega(Params P) {
    extern __shared__ __attribute__((aligned(16))) unsigned char smem[];
    LAS uchar* lds = (LAS uchar*)smem;
    uchar* ws = P.ws;
    const int G = gridDim.x, bid = blockIdx.x;
    volatile LAS unsigned* xst = (volatile LAS unsigned*)(lds + 131072);
    if (threadIdx.x == 0) { xst[0] = 0u; xst[1] = 0u; }
    __syncthreads();
    const XcdBarrier xb = xcd_barrier_post((unsigned*)(ws + WS_BAR), xst);
#define RUN(k) if (P.ph_lo <= (k) && (k) < P.ph_hi)
#define SEAM(k) if (P.ph_lo <= (k) && (k) + 1 < P.ph_hi) xcd_barrier(xb);
    RUN(0) phase_prep(P, lds);
    SEAM(0)
    RUN(1) phase_norm1(P);
    SEAM(1)
    RUN(2) {
        for (int rep = 0; rep < PROBE_P2; ++rep)
        { pg8::StaticOrder S; S.init(NTOK, NCOLS, G, bid);
          pg8::Gemm g{(const bf16_t*)(ws + WS_A), (const bf16_t*)(ws + WS_WIN), NTOK, NCOLS, 1024};
          EpiIn E{(bf16_t*)(ws + WS_UT), (bf16_t*)(ws + WS_Q), (bf16_t*)(ws + WS_K), (bf16_t*)(ws + WS_V), (bf16_t*)(ws + WS_C), (const float*)(ws + WS_ROPE)};
          pg8::gemm_phase<EpiIn, pg8::StaticOrder, true, true>(lds, g, S, E); }
        { pg8::StaticOrder S; S.init(NCTX, 1024, G, bid);
          pg8::Gemm g{(const bf16_t*)(ws + WS_HC), (const bf16_t*)(ws + WS_WIN) + (size_t)2048 * 1024, NCTX, 1024, 1024};
          EpiCtx E{(bf16_t*)(ws + WS_K), (bf16_t*)(ws + WS_V)};
          pg8::gemm_phase<EpiCtx, pg8::StaticOrder, true, true>(lds, g, S, E); }
        if (G > 32) { if (bid >= 32) tconv_range(P, threadIdx.x, NCOPY_EARLY, NCOPY_ALL, bid - 32, G - 32); }
        else tconv_range(P, threadIdx.x, NCOPY_EARLY, NCOPY_ALL, bid, G);
    }
    SEAM(2)
    RUN(3) {
        const int xcd = bid & 7, idx = bid >> 3;
        if (G == 256) {
            for (int rep = 0; rep < PROBE_HY; ++rep)
            for (int j = 0; j < 2; ++j) hyena_unit(P, lds, xcd * 64 + idx * 2 + j, j);
            hyena_flush(P, xcd * 64 + idx * 2);
        } else { for (int c2 = bid; c2 < 256; c2 += G) { for (int j = 0; j < 2; ++j) hyena_unit(P, lds, 2 * c2 + j, j); hyena_flush(P, 2 * c2); } }
        const float lam = ((const float*)(ws + WS_MISC))[0];
        if (G == 256) {
            for (int rep = 0; rep < PROBE_AT; ++rep)
            for (int j = 0; j < 4; ++j) { const int bh = j * 8 + xcd; attn_unit(P, lds, bh >> 2, bh & 3, idx, lam); }
        } else { for (int u = bid; u < 1024; u += G) attn_unit(P, lds, u >> 7, (u >> 5) & 3, u & 31, lam); }
        __syncthreads();
    }
    SEAM(3)
    RUN(4) {
        HalfOrder S; S.base.init(NTOK, 1024, G, bid); S.khalf_bytes = 512 * 2;
        pg8::Gemm g{(const bf16_t*)(ws + WS_D), (const bf16_t*)(ws + WS_WHY), NTOK, 1024, 512, 1024};
        EpiUpM E{(const bf16_t*)(ws + WS_C), (bf16_t*)(ws + WS_A)};
        pg8::gemm_phase<EpiUpM, HalfOrder, true, true>(lds, g, S, E);
    }
    SEAM(4)
    RUN(5) {
        pg8::StaticOrder S; S.init(NTOK, 1024, G, bid);
        pg8::Gemm g{(const bf16_t*)(ws + WS_A), (const bf16_t*)(ws + WS_WOUT), NTOK, 1024, 1024};
        EpiSsq E{(bf16_t*)(ws + WS_C), (float*)(ws + WS_SSQ)};
        pg8::gemm_phase<EpiSsq, pg8::StaticOrder, true, true>(lds, g, S, E);
    }
    SEAM(5)
    RUN(6) phase_mid(P);
    SEAM(6)
    RUN(7) for (int rep = 0; rep < PROBE_P7; ++rep) {
        pg8::StaticOrder S; S.init(NTOK, NGU, G, bid);
        pg8::Gemm g{(const bf16_t*)(ws + WS_A), (const bf16_t*)(ws + WS_WGU), NTOK, NGU, 1024};
        EpiGU E{(bf16_t*)(ws + WS_B)};
        pg8::gemm_phase<EpiGU, pg8::StaticOrder, true, true>(lds, g, S, E);
    }
    SEAM(7)
    RUN(8) {
        pg8::StaticOrder S; S.init(NTOK, 1024, G, bid);
        pg8::Gemm g{(const bf16_t*)(ws + WS_B), (const bf16_t*)(ws + WS_WDN), NTOK, 1024, DFF};
        EpiSsq E{(bf16_t*)(ws + WS_C + (size_t)NTOK * 1024 * 2), (float*)(ws + WS_SSQ) + NTOK};
        pg8::gemm_phase<EpiSsq, pg8::StaticOrder, true, true>(lds, g, S, E);
    }
    SEAM(8)
    RUN(9) phase_final(P);
}

extern "C" void kernel_launch(void* const* d_in, const int* in_sizes, int n_in, void* d_out, int out_size, void* d_ws, size_t ws_size, hipStream_t stream) {
    static int grid = 0;
    if (grid == 0) {
        if (n_in != 32 || ws_size < WS_END) { fprintf(stderr, "kernel_launch: unexpected n_in %d / ws_size %zu (need %zu)\n", n_in, ws_size, (size_t)WS_END); grid = -1; return; }
        int dev = 0, cus = 0, per_cu = 0;
        hipGetDevice(&dev);
        hipDeviceGetAttribute(&cus, hipDeviceAttributeMultiprocessorCount, dev);
        if (hipFuncSetAttribute((const void*)mega, hipFuncAttributeMaxDynamicSharedMemorySize, LDS_BYTES) != hipSuccess) { fprintf(stderr, "kernel_launch: hipFuncSetAttribute failed\n"); grid = -1; return; }
        if (hipOccupancyMaxActiveBlocksPerMultiprocessor(&per_cu, (const void*)mega, 512, LDS_BYTES) != hipSuccess || per_cu < 1) { fprintf(stderr, "kernel_launch: occupancy query says %d\n", per_cu); per_cu = 1; }
        (void)hipGetLastError();
        grid = cus * 1;
        fprintf(stderr, "kernel_launch: cus %d per_cu %d grid %d\n", cus, per_cu, grid);
    }
    if (grid < 0) return;
    if (hipMemsetAsync((char*)d_ws + WS_BAR, 0, 14336, stream) != hipSuccess) { fprintf(stderr, "kernel_launch: memset failed\n"); return; }
    Params p{};
    const float** pp = (const float**)&p;
    for (int i = 0; i < 32; ++i) pp[i] = (const float*)d_in[i];
    p.out = (float*)d_out; p.ws = (unsigned char*)d_ws;
#if N_LAUNCH == 1
    p.ph_lo = 0; p.ph_hi = NPH;
    hipLaunchKernelGGL(mega, dim3(grid), dim3(512), LDS_BYTES, stream, p);
#else
    for (int k = 0; k < NPH; ++k) { p.ph_lo = k; p.ph_hi = k + 1; hipLaunchKernelGGL(mega, dim3(grid), dim3(512), LDS_BYTES, stream, p); }
#endif
}
```

```cpp
#include <hip/hip_runtime.h>
#include <hip/hip_cooperative_groups.h>
#include <cstdio>
#include <cstdint>
namespace cg = cooperative_groups;
#define N_LAUNCH 1
namespace pg8 {
#define PG8_LAS __attribute__((address_space(3)))
typedef unsigned short bf16_t;
typedef short bf16x8 __attribute__((ext_vector_type(8)));
typedef float f32x4 __attribute__((ext_vector_type(4)));
typedef unsigned u32x4 __attribute__((ext_vector_type(4)));
constexpr int BM = 256, BK = 64, HALF = 128, HTB = HALF * BK * 2  , STAGE_BYTES = 8 * HTB, NXCD = 8, WGM = 8;

__host__ __device__ __forceinline__ int lds_byte(int r, int c) { const int st = (r >> 4) * 2 + (c >> 5), rr = r & 15, cc = c & 31, ob = rr * 64 + cc * 2; return st * 1024 + (ob ^ (((ob >> 9) & 1) << 5)); }
__host__ __device__ __forceinline__ void stage_rc(int b, int& R, int& C) { const int st = b / 1024, sb = b % 1024, swz = sb ^ (((sb >> 9) & 1) << 5); R = (st >> 1) * 16 + swz / 64; C = (st & 1) * 32 + (swz % 64) / 2; }
__host__ __device__ __forceinline__ int perm32(int rho) { const int n = rho >> 4, i = rho & 15; return 8 * (i >> 2) + 4 * n + (i & 3); }

struct Unit { int pm, pn; int koff = 0, half = 0; };
struct Gemm { const bf16_t* A; const bf16_t* Bt; int M, N, K; int ld = 0; };

struct StaticOrder {
    int nM, nN, nwg, G, c;
    __host__ __device__ void init(int M, int N, int G_, int c_) { nM = M / BM; nN = N / BM; nwg = nM * nN; G = G_; c = c_; }
    __host__ __device__ bool next(int i, Unit& u) const {
        const long L = (long)i * G + c; if (L >= nwg) return false;
        int wgid = (int)L; { const int q = nwg / NXCD, r = nwg % NXCD, xcd = wgid % NXCD, off = wgid / NXCD; wgid = (xcd < r ? xcd * (q + 1) : r * (q + 1) + (xcd - r) * q) + off; }
        const int nig = WGM * nN, gid = wgid / nig, fm = gid * WGM, gsz = (nM - fm) < WGM ? (nM - fm) : WGM;
        u.pm = fm + ((wgid % nig) % gsz); u.pn = (wgid % nig) / gsz; return true;
    }
    __device__ __forceinline__ void a_ready(const Unit&) const {}
    __device__ __forceinline__ void done(const Unit&) const {}
};
__device__ __forceinline__ unsigned cvt_pk_bf16(float lo, float hi) { unsigned r; asm volatile("v_cvt_pk_bf16_f32 %0, %1, %2" : "=v"(r) : "v"(lo), "v"(hi)); return r; }
template <class Epi, class Sched, bool ALIGN_EPI = false, bool SP2 = false>
__device__ __forceinline__ void gemm_phase(PG8_LAS unsigned char* lds, const Gemm g, const Sched& S, const Epi& E) {
    const int tid = threadIdx.x, wid = __builtin_amdgcn_readfirstlane(tid >> 6), lane = tid & 63, wr = wid >> 2, wc = wid & 3, fr = lane & 15, fq = lane >> 4;
    const int K = g.ld ? g.ld : g.K, nt = g.K / BK;
    unsigned voffA[2], voffB[2];
#pragma unroll
    for (int i = 0; i < 2; ++i) { int R, C; stage_rc(tid * 16 + i * 8192, R, C); const int Rb = Epi::PERM ? ((R & ~31) + perm32(R & 31)) : R;
        voffA[i] = (unsigned)(R * K + C) * 2u; voffB[i] = (unsigned)(Rb * K + C) * 2u; }
    const size_t kstep = (size_t)(BK * 2);
    const size_t hstep = (size_t)HALF * K * 2;
    const size_t tstep = 2 * hstep;
    const unsigned ldsw = (unsigned)wid * 1024u;
    const int aoff = lds_byte(wr * 64 + fr, fq * 8), boff = lds_byte(wc * 32 + fr, fq * 8);
#define PG8_SA(b, h) (((b) * 2 + (h)) * HTB)
#define PG8_SB(b, h) ((4 + (b) * 2 + (h)) * HTB)
#define PG8_STAGE(bufoff, gbase, voff) do { _Pragma("unroll") for (int _i = 0; _i < 2; ++_i) \
        __builtin_amdgcn_global_load_lds((const unsigned*)((const char*)(gbase) + (voff)[_i]), (PG8_LAS unsigned*)(lds + (bufoff) + ldsw + _i * 8192), 16, 0, 0); } while (0)
#define PG8_LDA(dst, b, h) do { _Pragma("unroll") for (int m = 0; m < 4; ++m) _Pragma("unroll") for (int k = 0; k < 2; ++k) dst[m][k] = *(const PG8_LAS bf16x8*)(lds + PG8_SA(b, h) + aoff + m * 2048 + k * 1024); } while (0)
#define PG8_LDB(dst, b, h) do { _Pragma("unroll") for (int n = 0; n < 2; ++n) _Pragma("unroll") for (int k = 0; k < 2; ++k) dst[n][k] = *(const PG8_LAS bf16x8*)(lds + PG8_SB(b, h) + boff + n * 2048 + k * 1024); } while (0)
#define PG8_MMA(ai, bj, At, Bt) do { __builtin_amdgcn_s_setprio(1); _Pragma("unroll") for (int m = 0; m < 4; ++m) _Pragma("unroll") for (int n = 0; n < 2; ++n) _Pragma("unroll") for (int k = 0; k < 2; ++k) \
        acc[ai][bj][m][n] = __builtin_amdgcn_mfma_f32_16x16x32_bf16(Bt[n][k], At[m][k], acc[ai][bj][m][n], 0, 0, 0); __builtin_amdgcn_s_setprio(0); } while (0)
#define PG8_WAIT_V(n) asm volatile("s_waitcnt vmcnt(" #n ")" ::: "memory")
#define PG8_WAIT_L(n) asm volatile("s_waitcnt lgkmcnt(" #n ")" ::: "memory")
#define PG8_BAR __builtin_amdgcn_s_barrier()
#define PG8_SCHED __builtin_amdgcn_sched_barrier(0)
    Unit cur, nxt; int ui = 0;
    if (!S.next(0, cur)) return;
    f32x4 acc[2][2][4][2];
#pragma unroll
    for (int a = 0; a < 2; ++a)
#pragma unroll
        for (int b = 0; b < 2; ++b)
#pragma unroll
            for (int m = 0; m < 4; ++m)
#pragma unroll
                for (int n = 0; n < 2; ++n) acc[a][b][m][n] = (f32x4){0.f, 0.f, 0.f, 0.f};
    bf16x8 At[4][2], B0[2][2], B1[2][2];
    const char* cA = (const char*)g.A + (size_t)cur.pm * tstep + cur.koff; const char* cB = (const char*)g.Bt + (size_t)cur.pn * tstep + cur.koff;
    S.a_ready(cur);
    if constexpr (SP2) {
        PG8_STAGE(PG8_SB(0, 0), cB, voffB); PG8_STAGE(PG8_SB(0, 1), cB + hstep, voffB); PG8_STAGE(PG8_SA(0, 0), cA, voffA); PG8_STAGE(PG8_SA(0, 1), cA + hstep, voffA);
        if (wr == 1) PG8_BAR;
        PG8_WAIT_V(2); PG8_BAR;
        PG8_STAGE(PG8_SB(1, 0), cB + kstep, voffB); PG8_STAGE(PG8_SA(1, 0), cA + kstep, voffA); PG8_STAGE(PG8_SB(1, 1), cB + hstep + kstep, voffB);
        PG8_WAIT_V(6); PG8_BAR;
    } else {
        PG8_STAGE(PG8_SB(0, 0), cB, voffB); PG8_STAGE(PG8_SA(0, 0), cA, voffA); PG8_STAGE(PG8_SB(0, 1), cB + hstep, voffB); PG8_STAGE(PG8_SA(0, 1), cA + hstep, voffA);
        if (wr == 1) PG8_BAR;
        PG8_WAIT_V(4); PG8_BAR;
        PG8_STAGE(PG8_SB(1, 0), cB + kstep, voffB); PG8_STAGE(PG8_SA(1, 0), cA + kstep, voffA); PG8_STAGE(PG8_SB(1, 1), cB + hstep + kstep, voffB);
        PG8_WAIT_V(6); PG8_BAR;
    }
    for (;;) {
        const bool has_next = S.next(ui + 1, nxt);
        const char* nA = has_next ? (const char*)g.A + (size_t)nxt.pm * tstep + nxt.koff : cA; const char* nB = has_next ? (const char*)g.Bt + (size_t)nxt.pn * tstep + nxt.koff : cB;
        for (int t = 0; t < nt; t += 2) {
            const bool last = (t == nt - 2);
            const char* a1 = cA + (size_t)(t + 1) * kstep;
            const char* a2 = last ? nA : cA + (size_t)(t + 2) * kstep; const char* b2 = last ? nB : cB + (size_t)(t + 2) * kstep;
            const char* a3 = a2 + kstep; const char* b3 = b2 + kstep;
            if (last && has_next) S.a_ready(nxt);
            if constexpr (SP2) {
            PG8_LDB(B0, 0, 0); PG8_LDB(B1, 0, 1); PG8_SCHED; PG8_LDA(At, 0, 0); PG8_STAGE(PG8_SA(1, 1), a1 + hstep, voffA);
            PG8_WAIT_V(8); PG8_WAIT_L(0); PG8_BAR; PG8_MMA(0, 0, At, B0); PG8_MMA(0, 1, At, B1); PG8_BAR; PG8_SCHED;
            PG8_LDA(At, 0, 1); PG8_STAGE(PG8_SB(0, 0), b2, voffB); PG8_STAGE(PG8_SB(0, 1), b2 + hstep, voffB); PG8_STAGE(PG8_SA(0, 0), a2, voffA);
            PG8_WAIT_V(8); PG8_WAIT_L(0); PG8_BAR; PG8_MMA(1, 0, At, B0); PG8_MMA(1, 1, At, B1); PG8_BAR; PG8_SCHED;
            PG8_LDB(B0, 1, 0); PG8_LDB(B1, 1, 1); PG8_SCHED; PG8_LDA(At, 1, 0); PG8_STAGE(PG8_SA(0, 1), a2 + hstep, voffA);
            PG8_WAIT_V(8); PG8_WAIT_L(0); PG8_BAR; PG8_MMA(0, 0, At, B0); PG8_MMA(0, 1, At, B1); PG8_BAR; PG8_SCHED;
            PG8_LDA(At, 1, 1); PG8_STAGE(PG8_SB(1, 0), b3, voffB); PG8_STAGE(PG8_SB(1, 1), b3 + hstep, voffB); PG8_STAGE(PG8_SA(1, 0), a3, voffA);
            PG8_WAIT_V(8); PG8_WAIT_L(0); PG8_BAR; PG8_MMA(1, 0, At, B0); PG8_MMA(1, 1, At, B1); PG8_BAR; PG8_SCHED;
            } else {
            PG8_LDB(B0, 0, 0); PG8_SCHED; PG8_LDA(At, 0, 0); PG8_STAGE(PG8_SA(1, 1), a1 + hstep, voffA);
            PG8_WAIT_L(8); PG8_BAR; PG8_WAIT_L(0); PG8_MMA(0, 0, At, B0); PG8_BAR; PG8_SCHED;
            PG8_LDB(B1, 0, 1); PG8_STAGE(PG8_SB(0, 0), b2, voffB);
            PG8_BAR; PG8_WAIT_L(0); PG8_MMA(0, 1, At, B1); PG8_BAR;
            PG8_LDA(At, 0, 1); PG8_STAGE(PG8_SA(0, 0), a2, voffA);
            PG8_BAR; PG8_WAIT_L(0); PG8_MMA(1, 0, At, B0); PG8_BAR; PG8_SCHED;
            PG8_STAGE(PG8_SB(0, 1), b2 + hstep, voffB);
            PG8_WAIT_V(6); PG8_BAR; PG8_MMA(1, 1, At, B1); PG8_BAR;
            PG8_LDB(B0, 1, 0); PG8_SCHED; PG8_LDA(At, 1, 0); PG8_STAGE(PG8_SA(0, 1), a2 + hstep, voffA);
            PG8_WAIT_L(8); PG8_BAR; PG8_WAIT_L(0); PG8_MMA(0, 0, At, B0); PG8_BAR; PG8_SCHED;
            PG8_LDB(B1, 1, 1); PG8_STAGE(PG8_SB(1, 0), b3, voffB);
            PG8_BAR; PG8_WAIT_L(0); PG8_MMA(0, 1, At, B1); PG8_BAR;
            PG8_LDA(At, 1, 1); PG8_STAGE(PG8_SA(1, 0), a3, voffA);
            PG8_BAR; PG8_WAIT_L(0); PG8_MMA(1, 0, At, B0); PG8_BAR; PG8_SCHED;
            PG8_STAGE(PG8_SB(1, 1), b3 + hstep, voffB);
            PG8_WAIT_V(6); PG8_BAR; PG8_MMA(1, 1, At, B1); PG8_BAR;
            }
        }
        if constexpr (ALIGN_EPI) { if (wr == 0) PG8_BAR; }
        if constexpr (!Epi::AFTER_DRAIN) { E(acc, cur, wr, wc, fr, fq); S.done(cur); }
        if (!has_next) break;
        if (E.zero_after(cur))
#pragma unroll
        for (int a = 0; a < 2; ++a)
#pragma unroll
            for (int b = 0; b < 2; ++b)
#pragma unroll
                for (int m = 0; m < 4; ++m)
#pragma unroll
                    for (int n = 0; n < 2; ++n) acc[a][b][m][n] = (f32x4){0.f, 0.f, 0.f, 0.f};
        cur = nxt; cA = nA; cB = nB; ++ui;
        if constexpr (ALIGN_EPI) { if (wr == 1) PG8_BAR; }
    }
    PG8_WAIT_V(0);
    if constexpr (!ALIGN_EPI) { if (wr == 0) PG8_BAR; }
    PG8_BAR;
    if constexpr (Epi::AFTER_DRAIN) { E.fused(acc, cur, wr, wc, fr, fq, lds, wid, lane); S.done(cur); }
#undef PG8_SA
#undef PG8_SB
#undef PG8_STAGE
#undef PG8_LDA
#undef PG8_LDB
#undef PG8_MMA
#undef PG8_WAIT_V
#undef PG8_WAIT_L
#undef PG8_BAR
#undef PG8_SCHED
}
}

#ifndef N_LAUNCH
#define N_LAUNCH 1
#endif
#ifndef AT_SGB
#define AT_SGB 1
#endif
#ifndef AT_VARIANT
#define AT_VARIANT 1
#endif
#ifndef PROBE_HY
#define PROBE_HY 1
#endif
#ifndef PROBE_AT
#define PROBE_AT 1
#endif
#ifndef PROBE_P2
#define PROBE_P2 1
#endif
#ifndef PROBE_P7
#define PROBE_P7 1
#endif
#define LAS __attribute__((address_space(3)))
#define DI __device__ __forceinline__
typedef unsigned char uchar;
using pg8::bf16_t; using pg8::bf16x8; using pg8::f32x4;
typedef float f32x16 __attribute__((ext_vector_type(16)));
typedef short s16x4 __attribute__((ext_vector_type(4)));
typedef float f32x2_t __attribute__((ext_vector_type(2)));
typedef __bf16 bf16x2_t __attribute__((ext_vector_type(2)));

constexpr int DM = 1024, NB = 8, SEQ = 4096, NTOK = NB * SEQ, CTXL = 256, NCTX = NB * CTXL, LKV = SEQ + CTXL;
constexpr int DHY = 512, NCOLS = 5120, DFF = 2816, NGU = 2 * DFF;
constexpr float EPSN = 1e-6f;
constexpr int LDS_BYTES = 131072 + 64;
constexpr int NPH = 10;

constexpr size_t al256(size_t x) { return (x + 255) & ~(size_t)255; }
constexpr size_t WS_WIN = 0;
constexpr size_t WS_WHY = WS_WIN + (size_t)NCOLS * DM * 2;
constexpr size_t WS_WATT = WS_WHY + (size_t)DM * DHY * 2;
constexpr size_t WS_WOUT = WS_WATT + (size_t)DM * DHY * 2;
constexpr size_t WS_WGU = WS_WOUT + (size_t)DM * DM * 2;
constexpr size_t WS_WDN = WS_WGU + (size_t)NGU * DM * 2;
constexpr size_t WS_R = WS_WDN + (size_t)DM * DFF * 2;
constexpr size_t WS_ADA = WS_R + (size_t)2 * DHY * 8192 * 2;
constexpr size_t WS_ROPE = al256(WS_ADA + (size_t)9 * 6144 * 4);
constexpr size_t WS_MISC = WS_ROPE + 64 * 32 * 4;
constexpr size_t WS_BAR = WS_MISC + 256;
constexpr size_t WS_SSQ = WS_BAR + 14336;
constexpr size_t WS_HC = WS_SSQ + (size_t)2 * NTOK * 4;
constexpr size_t WS_A = WS_HC + (size_t)NCTX * DM * 2;
constexpr size_t WS_B = WS_A + (size_t)NTOK * DM * 2;
constexpr size_t WS_UT = WS_B;
constexpr size_t WS_Q = WS_UT + (size_t)NB * 1536 * SEQ * 2;
constexpr size_t WS_K = WS_Q + (size_t)NTOK * 512 * 2;
constexpr size_t WS_V = WS_K + (size_t)NB * LKV * 512 * 2;
constexpr size_t WS_BEND = WS_V + (size_t)NB * LKV * 512 * 2;
constexpr size_t WS_C = WS_BEND;
constexpr size_t WS_D = WS_C + (size_t)NTOK * 2048 * 2;
constexpr size_t WS_END = WS_D + (size_t)2 * NTOK * 512 * 2;
static_assert((size_t)NTOK * DFF * 2 <= WS_BEND - WS_B, "ACT must fit region B");
static_assert(WS_END <= (size_t)536870912, "workspace map exceeds 512 MiB");

struct Params {
    const float *x, *c, *ctx, *c_ctx, *w_ada, *b_ada, *g_mix_pre, *g_mix_post, *g_ffn_pre, *g_ffn_post,
        *w_in, *hy_conv_w, *hy_conv_b, *f_w1, *f_b1, *f_w2, *f_b2, *f_w3, *f_b3, *f_freq, *hy_bias,
        *lq1, *lk1, *lq2, *lk2, *subln_g, *w_hy_up, *w_att_up, *w_out, *w_gate, *w_up, *w_down;
    float* out; unsigned char* ws; int ph_lo, ph_hi;
};

DI float bf2f(unsigned v) { return __uint_as_float(v << 16); }
DI unsigned pk2(float lo, float hi) { f32x2_t v = {lo, hi}; bf16x2_t b = __builtin_convertvector(v, bf16x2_t); return __builtin_bit_cast(unsigned, b); }
DI bf16_t f2bf(float x) { return (bf16_t)(pk2(x, 0.f) & 0xffffu); }
DI int crow(int r, int hi) { return (r & 3) + 8 * (r >> 2) + 4 * hi; }
DI float wave_sum(float v) {
#pragma unroll
    for (int o = 32; o > 0; o >>= 1) v += __shfl_xor(v, o);
    return v;
}
#define MFMA32(a, b, c) __builtin_amdgcn_mfma_f32_32x32x16_bf16((a), (b), (c), 0, 0, 0)
typedef short v4i16_t __attribute__((ext_vector_type(4)));
DI s16x4 vtr(LAS const uchar* p) { return __builtin_bit_cast(s16x4, __builtin_amdgcn_ds_read_tr16_b64_v4i16((LAS v4i16_t*)p)); }
DI bf16x8 pack8(const f32x16& x, int s) {
    typedef unsigned u32x4_t __attribute__((ext_vector_type(4)));
    u32x4_t p;
    if (s == 0) { p[0] = pk2(x[0], x[1]); p[1] = pk2(x[2], x[3]); p[2] = pk2(x[4], x[5]); p[3] = pk2(x[6], x[7]); }
    else        { p[0] = pk2(x[8], x[9]); p[1] = pk2(x[10], x[11]); p[2] = pk2(x[12], x[13]); p[3] = pk2(x[14], x[15]); }
    return __builtin_bit_cast(bf16x8, p);
}

#define EPI_ARGS const f32x4 (&acc)[2][2][4][2], const pg8::Unit& u, int wr, int wc, int fr, int fq
typedef unsigned u32x4v __attribute__((ext_vector_type(4)));
typedef unsigned u32x2v __attribute__((ext_vector_type(2)));

DI int win_colmap(int n) {
    if (n < 1536 || n >= 2560) return n;
    const int p = n & 31, a = p >> 3, bb = p & 7;
    const int orig = (bb < 4) ? 4 * a + bb : 16 + 4 * a + (bb - 4);
    return (n & ~31) + orig;
}

struct EpiIn {
    static constexpr bool PERM = true, AFTER_DRAIN = false;
    DI bool zero_after(const pg8::Unit&) const { return true; }
    bf16_t *UT, *Q, *K, *V, *G; const float* rope;
    DI void operator()(EPI_ARGS) const {
        const int row0 = u.pm * 256 + wr * 64 + fr;
        const int cb = u.pn * 256 + wc * 32 + 8 * fq;
        const int b = row0 >> 12, t0 = row0 & 4095;
        if (u.pn < 6) {
            const bool odd = fr & 1;
#pragma unroll
            for (int ai = 0; ai < 2; ++ai)
#pragma unroll
                for (int m = 0; m < 4; ++m) {
                    const int t = (t0 + ai * 128 + m * 16) & ~1;
#pragma unroll
                    for (int bj = 0; bj < 2; ++bj)
#pragma unroll
                        for (int n = 0; n < 2; ++n)
#pragma unroll
                            for (int jp = 0; jp < 2; ++jp) {
                                const float a0 = acc[ai][bj][m][n][2 * jp], a1 = acc[ai][bj][m][n][2 * jp + 1];
                                const float rcv = __shfl_xor(odd ? a0 : a1, 1);
                                const unsigned w = odd ? pk2(rcv, a1) : pk2(a0, rcv);
                                const int c = cb + bj * 128 + 4 * n + 2 * jp + (odd ? 1 : 0);
                                *(unsigned*)(UT + ((size_t)(b * 1536 + c) << 12) + t) = w;
                            }
                }
        } else if (u.pn < 10) {
            const bool isq = u.pn < 8;
            const float sc = isq ? 0.18033688011112042f : 1.0f;
#pragma unroll
            for (int ai = 0; ai < 2; ++ai)
#pragma unroll
                for (int m = 0; m < 4; ++m) {
                    const int t = t0 + ai * 128 + m * 16;
                    const int pos = (wc & 1) ? (t & 63) : (t >> 6);
                    const f32x4 cs = *(const f32x4*)(rope + pos * 32 + 4 * fq);
                    const f32x4 sn = *(const f32x4*)(rope + pos * 32 + 16 + 4 * fq);
#pragma unroll
                    for (int bj = 0; bj < 2; ++bj) {
                        const f32x4 x1 = acc[ai][bj][m][0], x2 = acc[ai][bj][m][1];
                        const f32x4 o1 = (x1 * cs - x2 * sn) * sc, o2 = (x1 * sn + x2 * cs) * sc;
                        u32x4v w; w.x = pk2(o1[0], o1[1]); w.y = pk2(o1[2], o1[3]); w.z = pk2(o2[0], o2[1]); w.w = pk2(o2[2], o2[3]);
                        const int c = cb + bj * 128;
                        if (isq) *(u32x4v*)(Q + (size_t)(b * 4096 + t) * 512 + (c - 1536)) = w;
                        else     *(u32x4v*)(K + (size_t)(b * LKV + t) * 512 + (c - 2048)) = w;
                    }
                }
        } else if (u.pn < 12) {
#pragma unroll
            for (int ai = 0; ai < 2; ++ai)
#pragma unroll
                for (int m = 0; m < 4; ++m) {
                    const int t = t0 + ai * 128 + m * 16;
#pragma unroll
                    for (int bj = 0; bj < 2; ++bj) {
                        const f32x4 a0 = acc[ai][bj][m][0], a1 = acc[ai][bj][m][1];
                        u32x4v w; w.x = pk2(a0[0], a0[1]); w.y = pk2(a0[2], a0[3]); w.z = pk2(a1[0], a1[1]); w.w = pk2(a1[2], a1[3]);
                        *(u32x4v*)(V + (size_t)(b * LKV + t) * 512 + (cb + bj * 128 - 2560)) = w;
                    }
                }
        } else {
#pragma unroll
            for (int ai = 0; ai < 2; ++ai)
#pragma unroll
                for (int m = 0; m < 4; ++m) {
                    const int row = row0 + ai * 128 + m * 16;
#pragma unroll
                    for (int bj = 0; bj < 2; ++bj) {
                        float s[8];
#pragma unroll
                        for (int n = 0; n < 2; ++n)
#pragma unroll
                            for (int j = 0; j < 4; ++j) s[4 * n + j] = __builtin_amdgcn_rcpf(1.0f + __builtin_amdgcn_exp2f(-1.4426950408889634f * acc[ai][bj][m][n][j]));
                        u32x4v w; w.x = pk2(s[0], s[1]); w.y = pk2(s[2], s[3]); w.z = pk2(s[4], s[5]); w.w = pk2(s[6], s[7]);
                        *(u32x4v*)(G + (size_t)row * 2048 + (cb + bj * 128 - 3072)) = w;
                    }
                }
        }
    }
};

struct EpiCtx {
    static constexpr bool PERM = true, AFTER_DRAIN = false;
    DI bool zero_after(const pg8::Unit&) const { return true; }
    bf16_t *K, *V;
    DI void operator()(EPI_ARGS) const {
        const int row0 = u.pm * 256 + wr * 64 + fr;
        const int cb = u.pn * 256 + wc * 32 + 8 * fq;
#pragma unroll
        for (int ai = 0; ai < 2; ++ai)
#pragma unroll
            for (int m = 0; m < 4; ++m) {
                const int row = row0 + ai * 128 + m * 16, b = row >> 8, tc = row & 255;
#pragma unroll
                for (int bj = 0; bj < 2; ++bj) {
                    const f32x4 a0 = acc[ai][bj][m][0], a1 = acc[ai][bj][m][1];
                    u32x4v w; w.x = pk2(a0[0], a0[1]); w.y = pk2(a0[2], a0[3]); w.z = pk2(a1[0], a1[1]); w.w = pk2(a1[2], a1[3]);
                    const int c = cb + bj * 128;
                    bf16_t* dst = (u.pn < 2) ? K + (size_t)(b * LKV + SEQ + tc) * 512 + c : V + (size_t)(b * LKV + SEQ + tc) * 512 + (c - 512);
                    *(u32x4v*)dst = w;
                }
            }
    }
};

struct EpiUpM {
    static constexpr bool PERM = true, AFTER_DRAIN = false;
    const bf16_t* G; bf16_t* O;
    DI bool zero_after(const pg8::Unit& u) const { return u.half != 0; }
    DI void mid(f32x4 (&acc)[2][2][4][2], const pg8::Unit& u, int wr, int wc, int fr, int fq) const {
        const int row0 = u.pm * 256 + wr * 64 + fr;
        const int cb = u.pn * 256 + wc * 32 + 8 * fq;
#pragma unroll
        for (int ai = 0; ai < 2; ++ai)
#pragma unroll
            for (int m = 0; m < 4; ++m) {
                const int row = row0 + ai * 128 + m * 16;
#pragma unroll
                for (int bj = 0; bj < 2; ++bj) {
                    const int c = cb + bj * 128;
                    const u32x4v gh = *(const u32x4v*)(G + (size_t)row * 2048 + c);
                    const u32x4v ga = *(const u32x4v*)(G + (size_t)row * 2048 + 1024 + c);
#pragma unroll
                    for (int q = 0; q < 4; ++q) {
                        const float r0 = bf2f(gh[q] & 0xffffu) * __builtin_amdgcn_rcpf(fmaxf(bf2f(ga[q] & 0xffffu), 1e-30f));
                        const float r1 = bf2f(gh[q] >> 16) * __builtin_amdgcn_rcpf(fmaxf(bf2f(ga[q] >> 16), 1e-30f));
                        acc[ai][bj][m][q >> 1][(q & 1) * 2] *= r0; acc[ai][bj][m][q >> 1][(q & 1) * 2 + 1] *= r1;
                    }
                    asm volatile("" : "+v"(acc[ai][bj][m][0]), "+v"(acc[ai][bj][m][1]) :: "memory");
                }
            }
    }
    DI void operator()(EPI_ARGS) const {
        if (u.half == 0) { mid(const_cast<f32x4 (&)[2][2][4][2]>(acc), u, wr, wc, fr, fq); return; }
        const int row0 = u.pm * 256 + wr * 64 + fr;
        const int cb = u.pn * 256 + wc * 32 + 8 * fq;
#pragma unroll
        for (int ai = 0; ai < 2; ++ai)
#pragma unroll
            for (int m = 0; m < 4; ++m) {
                const int row = row0 + ai * 128 + m * 16;
#pragma unroll
                for (int bj = 0; bj < 2; ++bj) {
                    const int c = cb + bj * 128;
                    const u32x4v ga = *(const u32x4v*)(G + (size_t)row * 2048 + 1024 + c);
                    u32x4v w;
#pragma unroll
                    for (int q = 0; q < 4; ++q)
                        w[q] = pk2(acc[ai][bj][m][q >> 1][(q & 1) * 2] * bf2f(ga[q] & 0xffffu), acc[ai][bj][m][q >> 1][(q & 1) * 2 + 1] * bf2f(ga[q] >> 16));
                    *(u32x4v*)(O + (size_t)row * 1024 + c) = w;
                }
            }
    }
};

struct EpiSsq {
    static constexpr bool PERM = true, AFTER_DRAIN = false;
    DI bool zero_after(const pg8::Unit&) const { return true; }
    bf16_t* O; float* ssq;
    DI void operator()(EPI_ARGS) const {
        const int row0 = u.pm * 256 + wr * 64 + fr;
        const int cb = u.pn * 256 + wc * 32 + 8 * fq;
#pragma unroll
        for (int ai = 0; ai < 2; ++ai)
#pragma unroll
            for (int m = 0; m < 4; ++m) {
                const int row = row0 + ai * 128 + m * 16;
                float ss = 0.f;
#pragma unroll
                for (int bj = 0; bj < 2; ++bj) {
                    const f32x4 a0 = acc[ai][bj][m][0], a1 = acc[ai][bj][m][1];
                    ss += a0[0] * a0[0] + a0[1] * a0[1] + a0[2] * a0[2] + a0[3] * a0[3] + a1[0] * a1[0] + a1[1] * a1[1] + a1[2] * a1[2] + a1[3] * a1[3];
                    u32x4v w; w.x = pk2(a0[0], a0[1]); w.y = pk2(a0[2], a0[3]); w.z = pk2(a1[0], a1[1]); w.w = pk2(a1[2], a1[3]);
                    *(u32x4v*)(O + (size_t)row * 1024 + cb + bj * 128) = w;
                }
                ss += __shfl_xor(ss, 16); ss += __shfl_xor(ss, 32);
                if (fq == 0) atomicAdd(ssq + row, ss);
            }
    }
};

struct EpiGU {
    static constexpr bool PERM = true, AFTER_DRAIN = false;
    DI bool zero_after(const pg8::Unit&) const { return true; }
    bf16_t* ACT;
    DI void operator()(EPI_ARGS) const {
        const int row0 = u.pm * 256 + wr * 64 + fr;
        const int cb = u.pn * 128 + wc * 16 + 4 * fq;
#pragma unroll
        for (int ai = 0; ai < 2; ++ai)
#pragma unroll
            for (int m = 0; m < 4; ++m) {
                const int row = row0 + ai * 128 + m * 16;
#pragma unroll
                for (int bj = 0; bj < 2; ++bj) {
                    const f32x4 g = acc[ai][bj][m][0], up = acc[ai][bj][m][1];
                    float r[4];
#pragma unroll
                    for (int j = 0; j < 4; ++j) r[j] = g[j] * __builtin_amdgcn_rcpf(1.0f + __builtin_amdgcn_exp2f(-1.4426950408889634f * g[j])) * up[j];
                    u32x2v w; w.x = pk2(r[0], r[1]); w.y = pk2(r[2], r[3]);
                    *(u32x2v*)(ACT + (size_t)row * DFF + cb + bj * 64) = w;
                }
            }
    }
};

struct HalfOrder {
    pg8::StaticOrder base; int khalf_bytes;
    DI bool next(int i, pg8::Unit& u) const { if (!base.next(i >> 1, u)) return false; u.half = i & 1; u.koff = (i & 1) * khalf_bytes; return true; }
    DI void a_ready(const pg8::Unit&) const {}
    DI void done(const pg8::Unit&) const {}
};

DI void tconv_ld(const Params& P, int it, int tid, f32x4 (&v)[8], bf16_t*& dp, int& K) {
    uchar* ws = P.ws;
    const float* sp; size_t stride; bf16_t* D; int ct, kt, r4;
    const int cl = 4 * (tid & 63), kg = tid >> 6; int kdst = 0;
    if (it < 320) { ct = it >> 4; kt = it & 15; K = 1024; D = (bf16_t*)(ws + WS_WIN); sp = P.w_in; stride = NCOLS;
        const int c4 = ct * 256 + cl; if (c4 < 1536 || c4 >= 2560) r4 = c4; else { const int o = c4 & 31; r4 = (c4 & ~31) + (o < 16 ? 2 * o : 2 * (o - 16) + 4); } }
    else if (it < 352) { const int i2 = it - 320; ct = i2 >> 3; kt = i2 & 7; K = 1024; D = (bf16_t*)(ws + WS_WHY); sp = P.w_hy_up; stride = 1024; r4 = ct * 256 + cl; }
    else if (it < 384) { const int i2 = it - 352; ct = i2 >> 3; kt = i2 & 7; K = 1024; D = (bf16_t*)(ws + WS_WHY); sp = P.w_att_up; stride = 1024; r4 = ct * 256 + cl; kdst = 512; }
    else if (it < 448) { const int i2 = it - 384; ct = i2 >> 4; kt = i2 & 15; K = 1024; D = (bf16_t*)(ws + WS_WOUT); sp = P.w_out; stride = 1024; r4 = ct * 256 + cl; }
    else if (it < 624) { const int i2 = it - 448; ct = i2 >> 4; kt = i2 & 15; K = 1024; D = (bf16_t*)(ws + WS_WGU); sp = P.w_gate; stride = DFF; r4 = 2 * (ct * 256 + cl); }
    else if (it < 800) { const int i2 = it - 624; ct = i2 >> 4; kt = i2 & 15; K = 1024; D = (bf16_t*)(ws + WS_WGU); sp = P.w_up; stride = DFF; r4 = 2 * (ct * 256 + cl) + 4; }
    else { const int i2 = it - 800; ct = i2 / 44; kt = i2 % 44; K = DFF; D = (bf16_t*)(ws + WS_WDN); sp = P.w_down; stride = 1024; r4 = ct * 256 + cl; }
    const int k0 = kt * 64 + kg * 8;
    sp += (size_t)k0 * stride + ct * 256 + cl;
#pragma unroll
    for (int j = 0; j < 8; ++j) v[j] = *(const f32x4*)(sp + (size_t)j * stride);
    dp = D + (size_t)r4 * K + k0 + kdst;
}
DI void tconv_st(const f32x4 (&v)[8], bf16_t* dp, int K) {
#pragma unroll
    for (int q = 0; q < 4; ++q) {
        u32x4v w; w.x = pk2(v[0][q], v[1][q]); w.y = pk2(v[2][q], v[3][q]); w.z = pk2(v[4][q], v[5][q]); w.w = pk2(v[6][q], v[7][q]);
        *(u32x4v*)(dp + (size_t)q * K) = w;
    }
}

constexpr int NCOPY_EARLY = 320, NCOPY_ALL = 976;
DI void tconv_range(const Params& P, int tid, int lo, int hi, int worker, int nworkers) {
    for (int it = lo + worker; it < hi; it += 2 * nworkers) {
        f32x4 va[8], vb[8]; bf16_t *da, *db = nullptr; int Ka, Kb = 0;
        const bool hb = it + nworkers < hi;
        tconv_ld(P, it, tid, va, da, Ka);
        if (hb) tconv_ld(P, it + nworkers, tid, vb, db, Kb);
        tconv_st(va, da, Ka);
        if (hb) tconv_st(vb, db, Kb);
    }
}
DI void phase_prep(const Params& P, LAS uchar* lds) {
    const int tid = threadIdx.x, G = gridDim.x, bid = blockIdx.x;
    const int gtid = bid * 512 + tid, gsz = G * 512;
    uchar* ws = P.ws;
    tconv_range(P, tid, 0, NCOPY_EARLY, bid, G);
    {
        LAS float* sl = (LAS float*)lds;
        LAS float* part = sl + 9216;
        float* ada = (float*)(ws + WS_ADA);
        __syncthreads();
        for (int i = tid; i < 9216; i += 512) { const int r = i >> 10, k = i & 1023; const float v = r < 8 ? P.c[r * 1024 + k] : P.c_ctx[k]; sl[i] = v / (1.0f + expf(-v)); }
        __syncthreads();
        for (int cbk = bid; cbk < 256; cbk += G) {
            if (tid < 504) {
                const int col = tid % 24, kp = tid / 24;
                float a[9];
#pragma unroll
                for (int r = 0; r < 9; ++r) a[r] = 0.f;
#pragma unroll 7
                for (int k = kp; k < 1024; k += 21) {
                    const float w = P.w_ada[(size_t)k * 6144 + cbk * 24 + col];
#pragma unroll
                    for (int r = 0; r < 9; ++r) a[r] += sl[r * 1024 + k] * w;
                }
#pragma unroll
                for (int r = 0; r < 9; ++r) part[kp * 216 + r * 24 + col] = a[r];
            }
            __syncthreads();
            if (tid < 216) {
                float s = 0.f;
                for (int kp = 0; kp < 21; ++kp) s += part[kp * 216 + tid];
                const int r = tid / 24, col = tid % 24;
                ada[r * 6144 + cbk * 24 + col] = s + P.b_ada[cbk * 24 + col];
            }
            __syncthreads();
        }
    }
    {
        LAS float* zb = (LAS float*)lds;
        LAS float* h1 = zb + 17 * 33 + 3;
        LAS float* h2 = h1 + 17 * 64;
        bf16_t* R = (bf16_t*)(ws + WS_R);
        for (int pb = bid; pb < 256; pb += G) {
            const int t0 = pb * 16;
            __syncthreads();
            if (tid < 272) {
                const int pp = tid >> 4, i = tid & 15, t = t0 + pp;
                const float w = (6.283185307179586f / 4096.0f) * (float)t;
                const float fr = 1e-4f + (float)i * ((15.0f - 1e-4f) / 15.0f);
                const float a = fr * w;
                zb[pp * 33 + 1 + i] = __cosf(a); zb[pp * 33 + 17 + i] = -__sinf(a);
                if (i == 0) zb[pp * 33] = (float)t * (1.0f / 4095.0f);
            }
            __syncthreads();
            for (int o = tid; o < 1088; o += 512) {
                const int pp = o >> 6, j = o & 63; float s = P.f_b1[j];
#pragma unroll
                for (int e = 0; e < 33; ++e) s += zb[pp * 33 + e] * P.f_w1[e * 64 + j];
                h1[o] = __sinf(P.f_freq[j] * s);
            }
            __syncthreads();
            for (int o = tid; o < 1088; o += 512) {
                const int pp = o >> 6, j = o & 63; float s = P.f_b2[j];
#pragma unroll 16
                for (int e = 0; e < 64; ++e) s += h1[pp * 64 + e] * P.f_w2[e * 64 + j];
                h2[o] = __sinf(P.f_freq[j] * s);
            }
            __syncthreads();
            const int col0 = tid * 4, n = col0 >> 10, dir = (col0 >> 9) & 1, off = dir ? 0 : 1;
            float acc[16][4];
#pragma unroll
            for (int pp = 0; pp < 16; ++pp)
#pragma unroll
                for (int j = 0; j < 4; ++j) acc[pp][j] = 0.f;
#pragma unroll 2
            for (int k = 0; k < 64; ++k) {
                const f32x4 w = *(const f32x4*)(P.f_w3 + (size_t)k * 2048 + col0);
#pragma unroll
                for (int pp = 0; pp < 16; ++pp) { const float hv = h2[(pp + off) * 64 + k];
#pragma unroll
                    for (int j = 0; j < 4; ++j) acc[pp][j] += hv * w[j]; }
            }
            LAS float* xch = h2 + 17 * 64;
            if (pb == 0) {
                if (dir == 0) {
                    float a0[4] = {0.f, 0.f, 0.f, 0.f};
#pragma unroll 2
                    for (int k = 0; k < 64; ++k) { const f32x4 w = *(const f32x4*)(P.f_w3 + (size_t)k * 2048 + col0); const float hv = h2[k];
#pragma unroll
                        for (int j = 0; j < 4; ++j) a0[j] += hv * w[j]; }
#pragma unroll
                    for (int j = 0; j < 4; ++j) xch[tid * 4 + j] = a0[j] + P.f_b3[col0 + j];
                }
                __syncthreads();
            }
            const float la = -3.0701134573253944f, lb = -15.350567286626973f;
#pragma unroll
            for (int j = 0; j < 4; ++j) {
                const int cch = (col0 + j) & 511;
                const float delta = fabsf(la + (lb - la) * ((float)cch / 511.0f));
                const float b3 = P.f_b3[col0 + j];
                bf16_t* Rc = R + ((size_t)(n * 512 + cch) << 13);
                float v[16];
                float dec = expf(-(float)(t0 + off) * (1.0f / 4095.0f) * delta); const float rr = expf(-delta * (1.0f / 4095.0f));
#pragma unroll
                for (int pp = 0; pp < 16; ++pp) { v[pp] = (acc[pp][j] + b3) * dec; dec *= rr; }
                if (dir == 0) {
                    if (pb == 255) v[15] = 0.f;
                    u32x4v w0, w1;
#pragma unroll
                    for (int i = 0; i < 4; ++i) { w0[i] = pk2(v[15 - 2 * i], v[14 - 2 * i]); w1[i] = pk2(v[7 - 2 * i], v[6 - 2 * i]); }
                    *(u32x4v*)(Rc + 4080 - t0) = w0; *(u32x4v*)(Rc + 4088 - t0) = w1;
                } else {
                    if (pb == 0) v[0] = xch[(tid - 128) * 4 + j];
                    u32x4v w0, w1;
#pragma unroll
                    for (int i = 0; i < 4; ++i) { w0[i] = pk2(v[2 * i], v[2 * i + 1]); w1[i] = pk2(v[8 + 2 * i], v[9 + 2 * i]); }
                    *(u32x4v*)(Rc + 4096 + t0) = w0; *(u32x4v*)(Rc + 4104 + t0) = w1;
                }
            }
        }
    }
    {
        float* rope = (float*)(ws + WS_ROPE);
        for (int i = gtid; i < 1024; i += gsz) {
            const int pos = i >> 4, f = i & 15;
            const float inv = powf(10000.0f, -(float)f / 16.0f), ang = (float)pos * inv;
            rope[pos * 32 + f] = cosf(ang); rope[pos * 32 + 16 + f] = sinf(ang);
        }
        if (gtid < 64) {
            float s1 = P.lq1[gtid] * P.lk1[gtid], s2 = P.lq2[gtid] * P.lk2[gtid];
            s1 = wave_sum(s1); s2 = wave_sum(s2);
            if (gtid == 0) ((float*)(ws + WS_MISC))[0] = expf(s1) - expf(s2) + 0.2f;
        }
        float* ssq = (float*)(ws + WS_SSQ);
        for (int i = gtid; i < 2 * NTOK; i += gsz) ssq[i] = 0.f;
    }
}

DI f32x4 ld_bf4(const bf16_t* p) { const u32x2v w = *(const u32x2v*)p; return (f32x4){bf2f(w.x & 0xffffu), bf2f(w.x >> 16), bf2f(w.y & 0xffffu), bf2f(w.y >> 16)}; }
DI void st_bf4(bf16_t* p, const f32x4 h) { u32x2v w; w.x = pk2(h[0], h[1]); w.y = pk2(h[2], h[3]); *(u32x2v*)p = w; }
DI float sq4(const f32x4 v) { return v[0] * v[0] + v[1] * v[1] + v[2] * v[2] + v[3] * v[3]; }
constexpr int RW = 4;
DI void phase_norm1(const Params& P) {
    const int lane = threadIdx.x & 63, gw = blockIdx.x * 8 + (threadIdx.x >> 6), nw = gridDim.x * 8;
    const float* ada = (const float*)(P.ws + WS_ADA);
    bf16_t* H = (bf16_t*)(P.ws + WS_A); bf16_t* HC = (bf16_t*)(P.ws + WS_HC);
    for (int row0 = gw * RW; row0 < NTOK + NCTX; row0 += nw * RW) {
        const bool lat = row0 < NTOK;
        const float* src = lat ? P.x + (size_t)row0 * 1024 : P.ctx + (size_t)(row0 - NTOK) * 1024;
        const float* ar = ada + (lat ? (row0 >> 12) : 8) * 6144;
        bf16_t* dst = lat ? H + (size_t)row0 * 1024 : HC + (size_t)(row0 - NTOK) * 1024;
        f32x4 v[RW][4]; float ss[RW];
#pragma unroll
        for (int r = 0; r < RW; ++r)
#pragma unroll
            for (int i = 0; i < 4; ++i) v[r][i] = __builtin_nontemporal_load((const f32x4*)(src + r * 1024 + i * 256 + lane * 4));
        f32x4 g[4], sh[4], sc[4];
#pragma unroll
        for (int i = 0; i < 4; ++i) { const int col = i * 256 + lane * 4; g[i] = *(const f32x4*)(P.g_mix_pre + col); sh[i] = *(const f32x4*)(ar + col); sc[i] = *(const f32x4*)(ar + 1024 + col); }
#pragma unroll
        for (int r = 0; r < RW; ++r) { ss[r] = sq4(v[r][0]) + sq4(v[r][1]) + sq4(v[r][2]) + sq4(v[r][3]); ss[r] = wave_sum(ss[r]); }
#pragma unroll
        for (int r = 0; r < RW; ++r) {
            const float rstd = rsqrtf(ss[r] * (1.0f / 1024.0f) + EPSN);
#pragma unroll
            for (int i = 0; i < 4; ++i) st_bf4(dst + r * 1024 + i * 256 + lane * 4, v[r][i] * rstd * g[i] * (sc[i] + 1.0f) + sh[i]);
        }
    }
}

DI void phase_mid(const Params& P) {
    const int lane = threadIdx.x & 63, gw = blockIdx.x * 8 + (threadIdx.x >> 6), nw = gridDim.x * 8;
    const float* ada = (const float*)(P.ws + WS_ADA);
    const bf16_t* MX = (const bf16_t*)(P.ws + WS_C); const float* ssq1 = (const float*)(P.ws + WS_SSQ);
    bf16_t* HF = (bf16_t*)(P.ws + WS_A);
    for (int row0 = gw * RW; row0 < NTOK; row0 += nw * RW) {
        const float* ar = ada + (row0 >> 12) * 6144;
        f32x4 v[RW][4], mv[RW][4]; float rs1[RW], ss[RW];
#pragma unroll
        for (int r = 0; r < RW; ++r) {
            rs1[r] = ssq1[row0 + r];
#pragma unroll
            for (int i = 0; i < 4; ++i) { const size_t o = (size_t)(row0 + r) * 1024 + i * 256 + lane * 4; v[r][i] = __builtin_nontemporal_load((const f32x4*)(P.x + o)); mv[r][i] = ld_bf4(MX + o); }
        }
#pragma unroll
        for (int r = 0; r < RW; ++r) {
            const float rstd1 = rsqrtf(rs1[r] * (1.0f / 1024.0f) + EPSN);
            ss[r] = 0.f;
#pragma unroll
            for (int i = 0; i < 4; ++i) {
                const int col = i * 256 + lane * 4;
                const f32x4 gp = *(const f32x4*)(P.g_mix_post + col), g1 = *(const f32x4*)(ar + 2048 + col);
                v[r][i] = v[r][i] + g1 * (mv[r][i] * rstd1 * gp);
                ss[r] += sq4(v[r][i]);
            }
            ss[r] = wave_sum(ss[r]);
        }
#pragma unroll
        for (int r = 0; r < RW; ++r) {
            const float rstd = rsqrtf(ss[r] * (1.0f / 1024.0f) + EPSN);
#pragma unroll
            for (int i = 0; i < 4; ++i) {
                const int col = i * 256 + lane * 4;
                const f32x4 g = *(const f32x4*)(P.g_ffn_pre + col), sh = *(const f32x4*)(ar + 3072 + col), sc = *(const f32x4*)(ar + 4096 + col);
                st_bf4(HF + (size_t)(row0 + r) * 1024 + col, v[r][i] * rstd * g * (sc + 1.0f) + sh);
            }
        }
    }
}

DI void phase_final(const Params& P) {
    constexpr int R9 = 2;
    const int lane = threadIdx.x & 63, gw = blockIdx.x * 8 + (threadIdx.x >> 6), nw = gridDim.x * 8;
    const float* ada = (const float*)(P.ws + WS_ADA);
    const bf16_t* MX = (const bf16_t*)(P.ws + WS_C); const bf16_t* F = (const bf16_t*)(P.ws + WS_C + (size_t)NTOK * 1024 * 2);
    const float* ssq1 = (const float*)(P.ws + WS_SSQ); const float* ssq2 = ssq1 + NTOK;
    for (int row0 = gw * R9; row0 < NTOK; row0 += nw * R9) {
        const float* ar = ada + (row0 >> 12) * 6144;
        f32x4 v[R9][4], mv[R9][4], fv[R9][4]; float rs1[R9], rs2[R9];
#pragma unroll
        for (int r = 0; r < R9; ++r) {
            rs1[r] = ssq1[row0 + r]; rs2[r] = ssq2[row0 + r];
#pragma unroll
            for (int i = 0; i < 4; ++i) { const size_t o = (size_t)(row0 + r) * 1024 + i * 256 + lane * 4; v[r][i] = __builtin_nontemporal_load((const f32x4*)(P.x + o)); mv[r][i] = ld_bf4(MX + o); fv[r][i] = ld_bf4(F + o); }
        }
#pragma unroll
        for (int r = 0; r < R9; ++r) {
            const float rstd1 = rsqrtf(rs1[r] * (1.0f / 1024.0f) + EPSN), rstd2 = rsqrtf(rs2[r] * (1.0f / 1024.0f) + EPSN);
#pragma unroll
            for (int i = 0; i < 4; ++i) {
                const int col = i * 256 + lane * 4;
                const f32x4 gp1 = *(const f32x4*)(P.g_mix_post + col), g1 = *(const f32x4*)(ar + 2048 + col);
                const f32x4 gp = *(const f32x4*)(P.g_ffn_post + col), g2 = *(const f32x4*)(ar + 5120 + col);
                const f32x4 x1 = v[r][i] + g1 * (mv[r][i] * rstd1 * gp1);
                __builtin_nontemporal_store(x1 + g2 * (fv[r][i] * rstd2 * gp), (f32x4*)(P.out + (size_t)(row0 + r) * 1024 + col));
            }
        }
    }
}

DI float xhalf_max(float m) { auto rr = __builtin_amdgcn_permlane32_swap(__float_as_uint(m), __float_as_uint(m), false, false); return fmaxf(__uint_as_float(rr[0]), __uint_as_float(rr[1])); }
DI float xhalf_sum(float m) { auto rr = __builtin_amdgcn_permlane32_swap(__float_as_uint(m), __float_as_uint(m), false, false); return __uint_as_float(rr[0]) + __uint_as_float(rr[1]); }
DI void glds16(const void* gsrc, unsigned lds_dst) { unsigned keep;
    asm volatile("s_mov_b32 %0, m0\n\ts_mov_b32 m0, %2\n\ts_nop 0\n\tglobal_load_lds_dwordx4 %1, off\n\ts_mov_b32 m0, %0" : "=&s"(keep) : "v"(gsrc), "s"(lds_dst) : "memory"); }
DI void attn_unit(const Params& P, LAS uchar* lds, int b, int h, int qb, float lam) {
    int tid_ = threadIdx.x; asm volatile("" : "+v"(tid_));
    const int tid = tid_, lane = tid & 63, wid = __builtin_amdgcn_readfirstlane(tid >> 6), map = wid >> 2, wq = wid & 3, r32 = lane & 31, hi = lane >> 5;
    const bf16_t* Qg = (const bf16_t*)(P.ws + WS_Q) + (size_t)(b * 4096 + qb * 128 + wq * 32 + r32) * 512 + h * 128 + map * 64 + hi * 8;
    bf16x8 qf[4];
#pragma unroll
    for (int s = 0; s < 4; ++s) qf[s] = *(const bf16x8*)(Qg + 16 * s);
    constexpr unsigned KS = 16384, VS0 = 3 * KS, VS = 16384;
    constexpr size_t TILE = (size_t)64 * 512;
    const bf16_t* kg[2]; const bf16_t* vg[2];
#pragma unroll
    for (int i = 0; i < 2; ++i) {
        const int j = 2 * wid + i;
        const int krow = 8 * (j & 7) + (lane >> 3), kc = (lane & 7) ^ ((krow >> 1) & 7);
        kg[i] = (const bf16_t*)(P.ws + WS_K) + (size_t)(b * LKV + krow) * 512 + h * 128 + (j >> 3) * 64 + kc * 8;
        const int vrow = 4 * j + (lane >> 4), vc = (lane & 15) ^ (4 * (vrow & 3));
        vg[i] = (const bf16_t*)(P.ws + WS_V) + (size_t)(b * LKV + vrow) * 512 + h * 128 + vc * 8;
    }
    const unsigned ldsw = (unsigned)wid * 2048u;
    const unsigned lds0 = (unsigned)(size_t)lds;
#define AT_DMA_K(T, SLOT) do { _Pragma("unroll") for (int i_ = 0; i_ < 2; ++i_) \
        glds16(kg[i_] + (size_t)(T) * TILE, (unsigned)__builtin_amdgcn_readfirstlane(lds0 + (SLOT) + ldsw + i_ * 1024)); } while (0)
#define AT_DMA_V(T, SLOT) do { _Pragma("unroll") for (int i_ = 0; i_ < 2; ++i_) \
        glds16(vg[i_] + (size_t)(T) * TILE, (unsigned)__builtin_amdgcn_readfirstlane(lds0 + (SLOT) + ldsw + i_ * 1024)); } while (0)
    unsigned kq[4], vq[4];
    { const int x = (r32 >> 1) & 7, q = (lane & 15) >> 2, p = lane & 3, blk = (lane >> 4) & 1;
#pragma unroll
      for (int s = 0; s < 4; ++s) kq[s] = map * 8192 + r32 * 128 + (((2 * s + hi) ^ x) << 4);
#pragma unroll
      for (int d = 0; d < 4; ++d) vq[d] = (4 * hi + q) * 256 + ((4 * (d ^ q) + 2 * blk + (p >> 1)) << 4) + 8 * (p & 1); }
#define AT_QK(KSLOT) do { _Pragma("unroll") for (int s = 0; s < 4; ++s) { \
        const bf16x8 a0 = *(LAS const bf16x8*)(lds + (KSLOT) + kq[s]); const bf16x8 a1 = *(LAS const bf16x8*)(lds + (KSLOT) + kq[s] + 4096); \
        if (s == 0) { st0 = MFMA32(a0, qf[0], negm); st1 = MFMA32(a1, qf[0], negm); } else { st0 = MFMA32(a0, qf[s], st0); st1 = MFMA32(a1, qf[s], st1); } } } while (0)
#define AT_PV(VSLOT) do { _Pragma("unroll") for (int ks = 0; ks < 4; ++ks) _Pragma("unroll") for (int d = 0; d < 4; ++d) { \
        const s16x4 lo = vtr(lds + (VSLOT) + vq[d] + (16 * ks) * 256); const s16x4 hh = vtr(lds + (VSLOT) + vq[d] + (16 * ks + 8) * 256); \
        const bf16x8 va = __builtin_shufflevector(lo, hh, 0, 1, 2, 3, 4, 5, 6, 7); ot[d] = MFMA32(va, pb[ks], ot[d]); } } while (0)
#define AT_ROWMAX(mx) do { float a_ = fmaxf(st0[0], st1[0]), b_ = fmaxf(st0[1], st1[1]); _Pragma("unroll") for (int r = 2; r < 16; r += 2) { a_ = fmaxf(a_, fmaxf(st0[r], st1[r])); b_ = fmaxf(b_, fmaxf(st0[r + 1], st1[r + 1])); } mx = xhalf_max(fmaxf(a_, b_)); } while (0)
#define AT_EXPS(PB) do { float s0_ = 0.f, s1_ = 0.f; _Pragma("unroll") for (int r = 0; r < 16; ++r) { st0[r] = __builtin_amdgcn_exp2f(st0[r]); st1[r] = __builtin_amdgcn_exp2f(st1[r]); s0_ += st0[r]; s1_ += st1[r]; } \
        lsum += s0_ + s1_; PB[0] = pack8(st0, 0); PB[1] = pack8(st0, 1); PB[2] = pack8(st1, 0); PB[3] = pack8(st1, 1); } while (0)
    __syncthreads();
    AT_DMA_K(0, 0); AT_DMA_K(1, KS); AT_DMA_V(0, VS0); AT_DMA_K(2, 2 * KS); AT_DMA_V(1, VS0 + VS);
    asm volatile("s_waitcnt vmcnt(0)" ::: "memory"); __syncthreads();
    f32x16 ot[4], st0, st1, negm;
#pragma unroll
    for (int r = 0; r < 16; ++r) { negm[r] = 0.f; ot[0][r] = 0.f; ot[1][r] = 0.f; ot[2][r] = 0.f; ot[3][r] = 0.f; }
    float mref, lsum = 0.f;
    bf16x8 pb[4];
    AT_QK(0);
    { float mx; AT_ROWMAX(mx); mref = mx;
#pragma unroll
      for (int r = 0; r < 16; ++r) { st0[r] -= mx; st1[r] -= mx; negm[r] = -mx; }
      AT_EXPS(pb); }
    AT_QK(KS);
    __syncthreads();
    unsigned vs_prev = VS0, vs_cur = VS0 + VS, vs_next = VS0 + 2 * VS;
    unsigned k_rd = 2 * KS, k_wr = 0;
    for (int t = 1; t < 68; ++t) {
        const unsigned kcur = k_rd, kwr = k_wr;
        if (t + 2 < 68) AT_DMA_K(t + 2, kwr);
        if (t + 1 < 68) AT_DMA_V(t + 1, vs_next);
        float mx; AT_ROWMAX(mx);
        AT_PV(vs_prev);
        if (__any(mx > 8.0f)) {
            const float dl = fmaxf(mx, 0.f), alpha = __builtin_amdgcn_exp2f(-dl);
            mref += dl; lsum *= alpha;
#pragma unroll
            for (int r = 0; r < 16; ++r) { st0[r] -= dl; st1[r] -= dl; negm[r] = -mref; ot[0][r] *= alpha; ot[1][r] *= alpha; ot[2][r] *= alpha; ot[3][r] *= alpha; }
        }
        AT_EXPS(pb);
        if (t + 1 < 68) AT_QK(kcur);
        asm volatile("s_waitcnt vmcnt(0)" ::: "memory"); __syncthreads();
        { const unsigned tmp_ = vs_prev; vs_prev = vs_cur; vs_cur = vs_next; vs_next = tmp_; }
        k_rd = k_wr; k_wr = (k_wr == 2 * KS) ? 0u : k_wr + KS;
    }
    AT_PV(vs_prev);
    __syncthreads();
#undef AT_DMA_K
#undef AT_DMA_V
#undef AT_QK
#undef AT_PV
#undef AT_ROWMAX
#undef AT_EXPS
    const float l = xhalf_sum(lsum);
    const float inv = 1.0f / l;
    LAS float* cbuf = (LAS float*)lds;
    if (map == 1) {
        const float sc = inv * lam;
#pragma unroll
        for (int d = 0; d < 4; ++d)
#pragma unroll
            for (int r = 0; r < 16; ++r) cbuf[(wq * 128 + 32 * d + crow(r, hi)) * 32 + r32] = ot[d][r] * sc;
    }
    __syncthreads();
    if (map == 0) {
        float ss = 0.f;
#pragma unroll
        for (int d = 0; d < 4; ++d)
#pragma unroll
            for (int r = 0; r < 16; ++r) { const float o = ot[d][r] * inv - cbuf[(wq * 128 + 32 * d + crow(r, hi)) * 32 + r32]; ot[d][r] = o; ss += o * o; }
        ss = xhalf_sum(ss);
        const float rs = rsqrtf(ss * (1.0f / 128.0f) + EPSN) * 0.8f;
        bf16_t* dst = (bf16_t*)(P.ws + WS_D) + (size_t)(b * 4096 + qb * 128 + wq * 32 + r32) * 1024 + 512 + h * 128;
#pragma unroll
        for (int d = 0; d < 4; ++d)
#pragma unroll
            for (int g = 0; g < 4; ++g) {
                const int d0 = 32 * d + 8 * g + 4 * hi;
                const f32x4 gg = *(const f32x4*)(P.subln_g + d0);
                u32x2v w; w.x = pk2(ot[d][4 * g] * rs * gg[0], ot[d][4 * g + 1] * rs * gg[1]); w.y = pk2(ot[d][4 * g + 2] * rs * gg[2], ot[d][4 * g + 3] * rs * gg[3]);
                *(u32x2v*)(dst + d0) = w;
            }
    }
}

constexpr int UPITCH = 5000, UPAD = 448;
constexpr unsigned HY_RE = 8 * UPITCH * 2, HY_RO = HY_RE + 16384 + 64;
DI void hyena_load_filter(const bf16_t* Rg, LAS uchar* lds, int tid) {
    for (int v = tid; v < 1024; v += 512) {
        const u32x4v a = *(const u32x4v*)(Rg + 8 * v);
        *(LAS u32x4v*)(lds + HY_RE + 16 * v) = a;
        const unsigned nx = (v < 1023) ? (unsigned)Rg[8 * v + 8] : 0u;
        u32x4v o; o.x = (a.x >> 16) | (a.y << 16); o.y = (a.y >> 16) | (a.z << 16); o.z = (a.z >> 16) | (a.w << 16); o.w = (a.w >> 16) | (nx << 16);
        *(LAS u32x4v*)(lds + HY_RO + 16 * v) = o;
    }
}
DI void hyena_unit(const Params& P, LAS uchar* lds, int c, int slot) {
    int tid_ = threadIdx.x; asm volatile("" : "+v"(tid_));
    const int tid = tid_, lane = tid & 63, w = __builtin_amdgcn_readfirstlane(tid >> 6), r32 = lane & 31, hi = lane >> 5;
    LAS bf16_t* U = (LAS bf16_t*)lds;
    const bf16_t* UT = (const bf16_t*)(P.ws + WS_UT);
    const bf16_t* R = (const bf16_t*)(P.ws + WS_R);
    bf16_t* scr = (bf16_t*)(P.ws + WS_A) + ((size_t)blockIdx.x * 2 + slot) * 32768;
    __syncthreads();
#pragma unroll 1
    for (int i = tid; i < 904; i += 512) {
        const int bb = i / 113, o = i % 113;
        const u32x4v z4 = {0u, 0u, 0u, 0u};
        *(LAS u32x4v*)(lds + bb * (UPITCH * 2) + (o < 56 ? o * 16 : (UPAD + 4096) * 2 + (o - 56) * 16)) = z4;
    }
    {
        const float w0 = P.hy_conv_w[c], w1 = P.hy_conv_w[1536 + c], w2 = P.hy_conv_w[3072 + c], cb = P.hy_conv_b[c];
#pragma unroll
        for (int i = 0; i < 8; ++i) {
            const int ch = tid + 512 * i, bb = ch >> 9, t8 = (ch & 511) * 8;
            const bf16_t* src = UT + ((size_t)(bb * 1536 + c) << 12) + t8;
            const u32x4v raw = *(const u32x4v*)src;
            float f[10];
            f[0] = t8 > 0 ? bf2f(src[-1]) : 0.f; f[9] = t8 + 8 < 4096 ? bf2f(src[8]) : 0.f;
#pragma unroll
            for (int q = 0; q < 4; ++q) { f[1 + 2 * q] = bf2f(raw[q] & 0xffffu); f[2 + 2 * q] = bf2f(raw[q] >> 16); }
            float o[8];
#pragma unroll
            for (int e = 0; e < 8; ++e) o[e] = w0 * f[e] + w1 * f[e + 1] + w2 * f[e + 2] + cb;
            u32x4v pw; pw.x = pk2(o[0], o[1]); pw.y = pk2(o[2], o[3]); pw.z = pk2(o[4], o[5]); pw.w = pk2(o[6], o[7]);
            *(LAS u32x4v*)(lds + (bb * UPITCH + UPAD + t8) * 2) = pw;
        }
    }
    hyena_load_filter(R + ((size_t)c << 13), lds, tid);
    __syncthreads();
    const int Iloc = r32 >> 3, bb = r32 & 7;
    const int ubase = (bb * UPITCH + UPAD + 64 * Iloc + 8 * hi) * 2;
    for (int ord = 0; ord < 2; ++ord) {
        f32x16 acc[2][2];
#pragma unroll
        for (int a = 0; a < 2; ++a)
#pragma unroll
            for (int m = 0; m < 2; ++m)
#pragma unroll
                for (int r = 0; r < 16; ++r) acc[a][m][r] = 0.f;
#define HY_LA(D, AF) do { const int q00 = 4096 - 64 * (D) - r32 + 8 * hi; \
            const unsigned abase = (q00 & 1) ? HY_RO + (unsigned)((q00 - 1) >> 1) * 4u : HY_RE + (unsigned)(q00 >> 1) * 4u; \
            _Pragma("unroll") for (int i = 0; i < 6; ++i) { u32x4v t_; \
                _Pragma("unroll") for (int e = 0; e < 4; ++e) t_[e] = *(LAS const unsigned*)(lds + abase + (8 * (i - 2) + e) * 4); AF[i] = __builtin_bit_cast(bf16x8, t_); } } while (0)
#define HY_LB(D, NBL, BF) do { _Pragma("unroll") for (int s = 0; s < 4; ++s) BF[s] = *(LAS const bf16x8*)(lds + ubase + (8 * w + 4 * (NBL) - (D)) * 128 + s * 32); } while (0)
#define HY_M(AF, BF, NBL) do { _Pragma("unroll") for (int s = 0; s < 4; ++s) { acc[NBL][0] = MFMA32(AF[s + 2], BF[s], acc[NBL][0]); acc[NBL][1] = MFMA32(AF[s], BF[s], acc[NBL][1]); } } while (0)
        {
            const int dh = 8 * w - 63, d0 = dh + 4, d1 = 8 * w + 3, dt = 8 * w + 7;
            bf16x8 afA[6], afB[6], bf0[4], bf1[4];
#pragma unroll 1
            for (int d = dh; d < d0; ++d) { HY_LA(d, afA); HY_LB(d, 0, bf0); HY_M(afA, bf0, 0); }
            HY_LA(d0, afA); HY_LB(d0, 0, bf0);
#pragma unroll 1
            for (int d = d0; d < d1; d += 2) {
                const int dn = d + 2 <= d1 ? d + 2 : d1;
                HY_LB(d, 1, bf1); HY_M(afA, bf0, 0); HY_LA(d + 1, afB); HY_LB(d + 1, 0, bf0); HY_M(afA, bf1, 1);
                HY_LB(d + 1, 1, bf1); HY_M(afB, bf0, 0); HY_LA(dn, afA); HY_LB(dn, 0, bf0); HY_M(afB, bf1, 1);
            }
            HY_LB(d1, 1, bf1); HY_M(afA, bf0, 0); HY_M(afA, bf1, 1);
#pragma unroll 1
            for (int d = d1 + 1; d <= dt; ++d) { HY_LA(d, afA); HY_LB(d, 1, bf1); HY_M(afA, bf1, 1); }
        }
#undef HY_LA
#undef HY_LB
#undef HY_M
        const int xch = 512 * (ord + 1) + c;
        const float w0 = P.hy_conv_w[xch], w1 = P.hy_conv_w[1536 + xch], w2 = P.hy_conv_w[3072 + xch], cb = P.hy_conv_b[xch];
        const float dbias = P.hy_bias[ord * 512 + c];
        const bf16_t* xg = UT + ((size_t)(bb * 1536 + xch) << 12);
        unsigned zp[2][2][8];
#pragma unroll
        for (int nbl = 0; nbl < 2; ++nbl)
#pragma unroll
            for (int mb = 0; mb < 2; ++mb) {
                const int base = 64 * (8 * w + 4 * nbl + Iloc) + 32 * mb;
                u32x4v W[4];
#pragma unroll
                for (int g = 0; g < 4; ++g) W[g] = *(const u32x4v*)(xg + base + 8 * g);
                const int eidx = hi ? base + 32 : base - 1;
                const unsigned ebits = (eidx >= 0 && eidx < 4096) ? (unsigned)xg[eidx] : 0u;
#pragma unroll
                for (int g = 0; g < 4; ++g) {
                    const int t4 = base + 8 * g + 4 * hi;
                    const u32x2v uu = *(LAS const u32x2v*)(lds + (bb * UPITCH + UPAD + t4) * 2);
                    const unsigned pd3 = (g > 0) ? W[g > 0 ? g - 1 : 0][3] : (ebits << 16), nd0 = (g < 3) ? W[g < 3 ? g + 1 : 3][0] : ebits;
                    const unsigned dA = hi ? W[g][1] : pd3, dB = hi ? W[g][2] : W[g][0], dC = hi ? W[g][3] : W[g][1], dD = hi ? nd0 : W[g][2];
                    float f[6];
                    f[0] = bf2f(dA >> 16); f[1] = bf2f(dB & 0xffffu); f[2] = bf2f(dB >> 16); f[3] = bf2f(dC & 0xffffu); f[4] = bf2f(dC >> 16); f[5] = bf2f(dD & 0xffffu);
                    const float u0 = bf2f(uu.x & 0xffffu), u1 = bf2f(uu.x >> 16), u2 = bf2f(uu.y & 0xffffu), u3 = bf2f(uu.y >> 16);
                    const float z0 = (w0 * f[0] + w1 * f[1] + w2 * f[2] + cb) * (acc[nbl][mb][4 * g + 0] + dbias * u0);
                    const float z1 = (w0 * f[1] + w1 * f[2] + w2 * f[3] + cb) * (acc[nbl][mb][4 * g + 1] + dbias * u1);
                    const float z2 = (w0 * f[2] + w1 * f[3] + w2 * f[4] + cb) * (acc[nbl][mb][4 * g + 2] + dbias * u2);
                    const float z3 = (w0 * f[3] + w1 * f[4] + w2 * f[5] + cb) * (acc[nbl][mb][4 * g + 3] + dbias * u3);
                    asm volatile("" ::: "memory");
                    if (ord == 0) { zp[nbl][mb][2 * g] = pk2(z0, z1); zp[nbl][mb][2 * g + 1] = pk2(z2, z3); }
                    else {
                        u32x2v pz; pz.x = pk2(z0, z1); pz.y = pk2(z2, z3);
                        *(u32x2v*)(scr + bb * 4096 + t4) = pz;
                    }
                }
            }
        if (ord == 0) {
            __syncthreads();
#pragma unroll
            for (int nbl = 0; nbl < 2; ++nbl)
#pragma unroll
                for (int mb = 0; mb < 2; ++mb)
#pragma unroll
                    for (int g = 0; g < 4; ++g) {
                        const int t4 = 64 * (8 * w + 4 * nbl + Iloc) + 32 * mb + 8 * g + 4 * hi;
                        u32x2v zz; zz.x = zp[nbl][mb][2 * g]; zz.y = zp[nbl][mb][2 * g + 1];
                        *(LAS u32x2v*)(lds + (bb * UPITCH + UPAD + t4) * 2) = zz;
                    }
            hyena_load_filter(R + ((size_t)(512 + c) << 13), lds, tid);
            __syncthreads();
        }
    }
}

DI void hyena_flush(const Params& P, int c0) {
    asm volatile("s_waitcnt vmcnt(0)" ::: "memory");
    __syncthreads();
    const unsigned long long* sa = (const unsigned long long*)((const bf16_t*)(P.ws + WS_A) + (size_t)blockIdx.x * 2 * 32768);
    const unsigned long long* sb = sa + 8192;
    bf16_t* Z = (bf16_t*)(P.ws + WS_D);
#pragma unroll 4
    for (int i = threadIdx.x; i < 8192; i += 512) {
        const unsigned long long a = __hip_atomic_load(sa + i, __ATOMIC_RELAXED, __HIP_MEMORY_SCOPE_AGENT), b = __hip_atomic_load(sb + i, __ATOMIC_RELAXED, __HIP_MEMORY_SCOPE_AGENT);
        const unsigned a0 = (unsigned)a, a1 = (unsigned)(a >> 32), b0 = (unsigned)b, b1 = (unsigned)(b >> 32);
        unsigned* zm = (unsigned*)(Z + (size_t)(4 * i) * 1024 + c0);
        zm[0] = (a0 & 0xffffu) | (b0 << 16); zm[512] = (a0 >> 16) | (b0 & 0xffff0000u); zm[1024] = (a1 & 0xffffu) | (b1 << 16); zm[1536] = (a1 >> 16) | (b1 & 0xffff0000u);
    }
    __syncthreads();
}

#define XB_TMO      128
#define XB_XCNT(j)  (256  + 64 * (j))
#define XB_XSUB(j)  (1280 + 64 * (j))
#define XB_XGEN(j)  (2304 + 64 * (j))
#define XB_TOP      3328
#define XB_TOPGEN   3392
#define XCD_BAR_WORDS 3456
#define XB_SPIN_CAP (1u << 18)

__device__ __forceinline__ unsigned xb_ld(unsigned* p)              { return __hip_atomic_load(p, __ATOMIC_RELAXED, __HIP_MEMORY_SCOPE_AGENT); }
__device__ __forceinline__ unsigned xb_add(unsigned* p, unsigned v) { return __hip_atomic_fetch_add(p, v, __ATOMIC_RELAXED, __HIP_MEMORY_SCOPE_AGENT); }
__device__ __forceinline__ unsigned xb_xcc_id() { return (unsigned)__builtin_amdgcn_s_getreg((3 << 11) | 20) & 0xFu; }
#define XB_SPIN(cond, bar) do { unsigned _sp = 0; while (cond) { __builtin_amdgcn_s_sleep(1); \
    if ((++_sp & 255u) == 0u) { if (xb_ld(&(bar)[XB_TMO])) break; if (_sp > XB_SPIN_CAP) { atomicAdd(&(bar)[XB_TMO], 1u); break; } } } } while (0)

struct XcdBarrier {
    unsigned* bar; unsigned x;
    volatile LAS unsigned* st;
};

__device__ __forceinline__ XcdBarrier xcd_barrier_post(unsigned* bar, volatile LAS unsigned* st) {
    XcdBarrier b; b.bar = bar; b.x = xb_xcc_id(); b.st = st;
    if (threadIdx.x == 0) (void)xb_add(&bar[XB_XCNT(b.x)], 1u);
    return b;
}
__device__ __forceinline__ void xcd_barrier_complete(unsigned* bar, unsigned x, unsigned& nloc, unsigned& nx) {
    const unsigned G = gridDim.x * gridDim.y * gridDim.z;
    unsigned sum, cnt, mine, sp = 0u;
    for (;;) {
        sum = 0u; cnt = 0u; mine = 0u;
#pragma unroll
        for (unsigned j = 0; j < 16; ++j) { const unsigned c = xb_ld(&bar[XB_XCNT(j)]); sum += c; cnt += (c > 0u) ? 1u : 0u; mine = (j == x) ? c : mine; }
        if (sum == G) break;
        __builtin_amdgcn_s_sleep(1);
        if ((++sp & 255u) == 0u) { if (xb_ld(&bar[XB_TMO])) break; if (sp > XB_SPIN_CAP) { atomicAdd(&bar[XB_TMO], 1u); break; } }
    }
    nloc = mine > 0u ? mine : 1u; nx = cnt > 0u ? cnt : 1u;
}

__device__ __forceinline__ void xcd_barrier(const XcdBarrier& b) {
    asm volatile("s_waitcnt vmcnt(0)" ::: "memory");
    __syncthreads();
    if (threadIdx.x == 0) {
        unsigned* bar = b.bar;
        __builtin_amdgcn_s_waitcnt(0);
        unsigned nloc = b.st[0], nx = b.st[1];
        if (nloc == 0u) { xcd_barrier_complete(bar, b.x, nloc, nx); b.st[0] = nloc; b.st[1] = nx; }
        const unsigned old = xb_add(&bar[XB_XSUB(b.x)], 1u);
        const unsigned gen = old / nloc;
        if (old + 1u == (gen + 1u) * nloc) {
            __builtin_amdgcn_fence(__ATOMIC_RELEASE, "agent");
            asm volatile("s_waitcnt vmcnt(0)" ::: "memory");
            const unsigned og = xb_add(&bar[XB_TOP], 1u);
            const unsigned tg = og / nx;
            if (og + 1u == (tg + 1u) * nx) xb_add(&bar[XB_TOPGEN], 1u);
            else XB_SPIN(xb_ld(&bar[XB_TOPGEN]) == tg, bar);
            __builtin_amdgcn_fence(__ATOMIC_ACQUIRE, "agent");
            xb_add(&bar[XB_XGEN(b.x)], 1u);
            asm volatile("s_waitcnt vmcnt(0)" ::: "memory");
        } else {
            XB_SPIN(xb_ld(&bar[XB_XGEN(b.x)]) == gen, bar);
            __builtin_amdgcn_fence(__ATOMIC_ACQUIRE, "agent");
            asm volatile("s_waitcnt vmcnt(0)" ::: "memory");
        }
    }
    __syncthreads();
}


__global__ void __launch_bounds__(512, 2) mega(Params P) {
    extern __shared__ __attribute__((aligned(16))) unsigned char smem[];
    LAS uchar* lds = (LAS uchar*)smem;
    uchar* ws = P.ws;
    const int G = gridDim.x, bid = blockIdx.x;
    volatile LAS unsigned* xst = (volatile LAS unsigned*)(lds + 131072);
    if (threadIdx.x == 0) { xst[0] = 0u; xst[1] = 0u; }
    __syncthreads();
    const XcdBarrier xb = xcd_barrier_post((unsigned*)(ws + WS_BAR), xst);
#define RUN(k) if (P.ph_lo <= (k) && (k) < P.ph_hi)
#define SEAM(k) if (P.ph_lo <= (k) && (k) + 1 < P.ph_hi) xcd_barrier(xb);
    RUN(0) phase_prep(P, lds);
    SEAM(0)
    RUN(1) phase_norm1(P);
    SEAM(1)
    RUN(2) {
        for (int rep = 0; rep < PROBE_P2; ++rep)
        { pg8::StaticOrder S; S.init(NTOK, NCOLS, G, bid);
          pg8::Gemm g{(const bf16_t*)(ws + WS_A), (const bf16_t*)(ws + WS_WIN), NTOK, NCOLS, 1024};
          EpiIn E{(bf16_t*)(ws + WS_UT), (bf16_t*)(ws + WS_Q), (bf16_t*)(ws + WS_K), (bf16_t*)(ws + WS_V), (bf16_t*)(ws + WS_C), (const float*)(ws + WS_ROPE)};
          pg8::gemm_phase<EpiIn, pg8::StaticOrder, true, true>(lds, g, S, E); }
        { pg8::StaticOrder S; S.init(NCTX, 1024, G, bid);
          pg8::Gemm g{(const bf16_t*)(ws + WS_HC), (const bf16_t*)(ws + WS_WIN) + (size_t)2048 * 1024, NCTX, 1024, 1024};
          EpiCtx E{(bf16_t*)(ws + WS_K), (bf16_t*)(ws + WS_V)};
          pg8::gemm_phase<EpiCtx, pg8::StaticOrder, true, true>(lds, g, S, E); }
        if (G > 32) { if (bid >= 32) tconv_range(P, threadIdx.x, NCOPY_EARLY, NCOPY_ALL, bid - 32, G - 32); }
        else tconv_range(P, threadIdx.x, NCOPY_EARLY, NCOPY_ALL, bid, G);
    }
    SEAM(2)
    RUN(3) {
        const int xcd = bid & 7, idx = bid >> 3;
        if (G == 256) {
            for (int rep = 0; rep < PROBE_HY; ++rep)
            for (int j = 0; j < 2; ++j) hyena_unit(P, lds, xcd * 64 + idx * 2 + j, j);
            hyena_flush(P, xcd * 64 + idx * 2);
        } else { for (int c2 = bid; c2 < 256; c2 += G) { for (int j = 0; j < 2; ++j) hyena_unit(P, lds, 2 * c2 + j, j); hyena_flush(P, 2 * c2); } }
        const float lam = ((const float*)(ws + WS_MISC))[0];
        if (G == 256) {
            for (int rep = 0; rep < PROBE_AT; ++rep)
            for (int j = 0; j < 4; ++j) { const int bh = j * 8 + xcd; attn_unit(P, lds, bh >> 2, bh & 3, idx, lam); }
        } else { for (int u = bid; u < 1024; u += G) attn_unit(P, lds, u >> 7, (u >> 5) & 3, u & 31, lam); }
        __syncthreads();
    }
    SEAM(3)
    RUN(4) {
        HalfOrder S; S.base.init(NTOK, 1024, G, bid); S.khalf_bytes = 512 * 2;
        pg8::Gemm g{(const bf16_t*)(ws + WS_D), (const bf16_t*)(ws + WS_WHY), NTOK, 1024, 512, 1024};
        EpiUpM E{(const bf16_t*)(ws + WS_C), (bf16_t*)(ws + WS_A)};
        pg8::gemm_phase<EpiUpM, HalfOrder, true, true>(lds, g, S, E);
    }
    SEAM(4)
    RUN(5) {
        pg8::StaticOrder S; S.init(NTOK, 1024, G, bid);
        pg8::Gemm g{(const bf16_t*)(ws + WS_A), (const bf16_t*)(ws + WS_WOUT), NTOK, 1024, 1024};
        EpiSsq E{(bf16_t*)(ws + WS_C), (float*)(ws + WS_SSQ)};
        pg8::gemm_phase<EpiSsq, pg8::StaticOrder, true, true>(lds, g, S, E);
    }
    SEAM(5)
    RUN(6) phase_mid(P);
    SEAM(6)
    RUN(7) for (int rep = 0; rep < PROBE_P7; ++rep) {
        pg8::StaticOrder S; S.init(NTOK, NGU, G, bid);
        pg8::Gemm g{(const bf16_t*)(ws + WS_A), (const bf16_t*)(ws + WS_WGU), NTOK, NGU, 1024};
        EpiGU E{(bf16_t*)(ws + WS_B)};
        pg8::gemm_phase<EpiGU, pg8::StaticOrder, true, true>(lds, g, S, E);
    }
    SEAM(7)
    RUN(8) {
        pg8::StaticOrder S; S.init(NTOK, 1024, G, bid);
        pg8::Gemm g{(const bf16_t*)(ws + WS_B), (const bf16_t*)(ws + WS_WDN), NTOK, 1024, DFF};
        EpiSsq E{(bf16_t*)(ws + WS_C + (size_t)NTOK * 1024 * 2), (float*)(ws + WS_SSQ) + NTOK};
        pg8::gemm_phase<EpiSsq, pg8::StaticOrder, true, true>(lds, g, S, E);
    }
    SEAM(8)
    RUN(9) phase_final(P);
}

extern "C" void kernel_launch(void* const* d_in, const int* in_sizes, int n_in, void* d_out, int out_size, void* d_ws, size_t ws_size, hipStream_t stream) {
    static int grid = 0;
    if (grid == 0) {
        if (n_in != 32 || ws_size < WS_END) { fprintf(stderr, "kernel_launch: unexpected n_in %d / ws_size %zu (need %zu)\n", n_in, ws_size, (size_t)WS_END); grid = -1; return; }
        int dev = 0, cus = 0, per_cu = 0;
        hipGetDevice(&dev);
        hipDeviceGetAttribute(&cus, hipDeviceAttributeMultiprocessorCount, dev);
        if (hipFuncSetAttribute((const void*)mega, hipFuncAttributeMaxDynamicSharedMemorySize, LDS_BYTES) != hipSuccess) { fprintf(stderr, "kernel_launch: hipFuncSetAttribute failed\n"); grid = -1; return; }
        if (hipOccupancyMaxActiveBlocksPerMultiprocessor(&per_cu, (const void*)mega, 512, LDS_BYTES) != hipSuccess || per_cu < 1) { fprintf(stderr, "kernel_launch: occupancy query says %d\n", per_cu); per_cu = 1; }
        (void)hipGetLastError();
        grid = cus * 1;
        fprintf(stderr, "kernel_launch: cus %d per_cu %d grid %d\n", cus, per_cu, grid);
    }
    if (grid < 0) return;
    if (hipMemsetAsync((char*)d_ws + WS_BAR, 0, 14336, stream) != hipSuccess) { fprintf(stderr, "kernel_launch: memset failed\n"); return; }
    Params p{};
    const float** pp = (const float**)&p;
    for (int i = 0; i < 32; ++i) pp[i] = (const float*)d_in[i];
    p.out = (float*)d_out; p.ws = (unsigned char*)d_ws;
#if N_LAUNCH == 1
    p.ph_lo = 0; p.ph_hi = NPH;
    hipLaunchKernelGGL(mega, dim3(grid), dim3(512), LDS_BYTES, stream, p);
#else
    for (int k = 0; k < NPH; ++k) { p.ph_lo = k; p.ph_hi = k + 1; hipLaunchKernelGGL(mega, dim3(grid), dim3(512), LDS_BYTES, stream, p); }
#endif
}
```
